# Optimizing an MI355X kernel written in HIP

```python
import jax, jax.numpy as jnp
from jax import lax
import numpy as np

D_MODEL = 1024
BATCH = 8
SEQ = 2048
DEPTH = 1
DEC_BATCH = 128
DEC_SEQ = 8
PAST_LEN = 16384
PAGE_SIZE = 128

EPS = 1e-6
POOL_WINDOWS = (2, 4, 8, 16)
N_POOL_GROUPS = len(POOL_WINDOWS)
D_POOL = D_MODEL // 2
POOL_GROUP = D_POOL // N_POOL_GROUPS
POOL_BUF = max(POOL_WINDOWS) - 1
SSM_EXPAND = 2
D_INNER = SSM_EXPAND * D_MODEL
HEAD_DIM = 64
N_HEADS = D_INNER // HEAD_DIM
N_BC_GROUPS = 4
HEADS_PER_GROUP = N_HEADS // N_BC_GROUPS
D_STATE = 128
CONV_W = 4
D_XBC = D_INNER + 2 * N_BC_GROUPS * D_STATE
CHUNK = 128
N_BRANCH = 2
SPLITS = (D_POOL, 2 * D_POOL, 2 * D_POOL + D_INNER, 2 * D_POOL + D_INNER + D_XBC,
          2 * D_POOL + D_INNER + D_XBC + N_HEADS)
IN_COLS = 2 * D_POOL + D_INNER + D_XBC + N_HEADS + N_BRANCH * D_MODEL

kernel_name = "pool_ssd_gated_hybrid_step"


def rmsnorm(x, g):
    xf = x.astype(jnp.float32)
    y = xf * lax.rsqrt(jnp.mean(xf * xf, axis=-1, keepdims=True) + EPS)
    return (y * g.astype(jnp.float32)).astype(x.dtype)


def pool_mix(u, buf, pos0, pool_w, pool_scale):
    b, L, _ = u.shape
    xp = jnp.concatenate([buf.astype(u.dtype), u], axis=1)
    cs = jnp.pad(jnp.cumsum(xp.astype(jnp.float32), axis=1), ((0, 0), (1, 0), (0, 0)))
    pos = pos0 + jnp.arange(L)
    means = []
    for gi, w in enumerate(POOL_WINDOWS):
        sl = slice(gi * POOL_GROUP, (gi + 1) * POOL_GROUP)
        s = cs[:, POOL_BUF + 1:POOL_BUF + 1 + L, sl] - cs[:, POOL_BUF + 1 - w:POOL_BUF + 1 - w + L, sl]
        cnt = jnp.minimum(pos + 1, w).astype(jnp.float32)
        means.append(s / cnt[None, :, None])
    d = jnp.concatenate(means, axis=-1) - u.astype(jnp.float32)
    d = d.reshape(b, L, N_POOL_GROUPS, POOL_GROUP)
    y = jnp.einsum('blgc,gcd->blgd', d, pool_w.astype(jnp.float32)).reshape(b, L, D_POOL)
    y = y * pool_scale.astype(jnp.float32)
    return y.astype(u.dtype), xp[:, -POOL_BUF:]


def causal_conv(xbc, buf, w, bias):
    L = xbc.shape[1]
    xp = jnp.concatenate([buf.astype(xbc.dtype), xbc], axis=1)
    y = bias[None, None, :] + sum(xp[:, k:k + L] * w[k][None, None, :] for k in range(CONV_W))
    return y, xp[:, -(CONV_W - 1):]


def ssd(x, dt, A, B, C, state0):
    b, L = x.shape[:2]
    Q = CHUNK if L % CHUNK == 0 else L
    nc = L // Q

    def to_chunks(t):
        return jnp.moveaxis(t.reshape((b, nc, Q) + t.shape[2:]), 1, 0)

    xc = to_chunks(x.reshape(b, L, N_BC_GROUPS, HEADS_PER_GROUP, HEAD_DIM))
    dtc = to_chunks(dt.reshape(b, L, N_BC_GROUPS, HEADS_PER_GROUP))
    Bc, Cc = to_chunks(B), to_chunks(C)
    Ag = A.reshape(N_BC_GROUPS, HEADS_PER_GROUP)
    mask = jnp.tril(jnp.ones((Q, Q), dtype=bool))[None, :, :, None, None]

    def step(h, inp):
        xq, dq, Bq, Cq = inp
        acs = jnp.cumsum(dq * Ag, axis=1)
        seg = acs[:, :, None] - acs[:, None, :]
        decay = jnp.exp(jnp.where(mask, seg, -jnp.inf))
        cb = jnp.einsum('bign,bjgn->bijg', Cq, Bq)
        att = cb[..., None] * decay * dq[:, None]
        y = jnp.einsum('bijge,bjgep->bigep', att, xq)
        y = y + jnp.einsum('bign,bige,bgepn->bigep', Cq, jnp.exp(acs), h)
        last = acs[:, -1]
        w_in = jnp.exp(last[:, None] - acs) * dq
        h = h * jnp.exp(last)[..., None, None] + jnp.einsum('bjgn,bjge,bjgep->bgepn', Bq, w_in, xq)
        return h, y

    h0 = state0.astype(jnp.float32).reshape(b, N_BC_GROUPS, HEADS_PER_GROUP, HEAD_DIM, D_STATE)
    hT, ys = lax.scan(step, h0, (xc, dtc, Bc, Cc))
    y = jnp.moveaxis(ys, 0, 1).reshape(b, L, N_HEADS, HEAD_DIM)
    return y, hT.reshape(b, N_HEADS, HEAD_DIM, D_STATE)


def layer(x, c, pos0, pool_buf, conv_buf, ssm_state, w_ada, b_ada, norm_g, w_in, conv_w, conv_b,
          dt_bias, a_log, d_skip, ssm_norm_g, pool_w, pool_scale, w_pool_out, w_ssm_out, w_o):
    b, L, _ = x.shape
    mod = jax.nn.silu(c) @ w_ada + b_ada
    shift, scale, gate = jnp.split(mod, 3, axis=-1)
    h = rmsnorm(x, norm_g) * (1 + scale[:, None]) + shift[:, None]
    proj = h @ w_in
    u_pool, z_pool, z_ssm, xbc, dt_raw, g_raw = jnp.split(proj, SPLITS, axis=-1)
    p, pool_new = pool_mix(u_pool, pool_buf, pos0, pool_w, pool_scale)
    p = (p * jax.nn.silu(z_pool)) @ w_pool_out
    xbc_c, conv_new = causal_conv(xbc, conv_buf, conv_w, conv_b)
    xbc_c = jax.nn.silu(xbc_c).astype(jnp.float32)
    xs = xbc_c[..., :D_INNER].reshape(b, L, N_HEADS, HEAD_DIM)
    Bm = xbc_c[..., D_INNER:D_INNER + N_BC_GROUPS * D_STATE].reshape(b, L, N_BC_GROUPS, D_STATE)
    Cm = xbc_c[..., D_INNER + N_BC_GROUPS * D_STATE:].reshape(b, L, N_BC_GROUPS, D_STATE)
    dt = jax.nn.softplus(dt_raw.astype(jnp.float32) + dt_bias.astype(jnp.float32))
    A = -jnp.exp(a_log.astype(jnp.float32))
    y, ssm_new = ssd(xs, dt, A, Bm, Cm, ssm_state)
    y = (y + d_skip.astype(jnp.float32)[:, None] * xs).reshape(b, L, D_INNER)
    y = rmsnorm(y * jax.nn.silu(z_ssm.astype(jnp.float32)), ssm_norm_g)
    s = y.astype(x.dtype) @ w_ssm_out
    gates = jax.nn.sigmoid(g_raw)
    m = gates[..., :D_MODEL] * p + gates[..., D_MODEL:] * s
    x = x + gate[:, None] * (m @ w_o)
    return x, pool_new, conv_new, ssm_new


def setup_inputs(seed: int = 0) -> dict:
    key = jax.random.key(seed)
    ks = jax.random.split(key, 24)
    nrm = lambda k, shape, s: jax.random.normal(k, shape, jnp.float32) * s
    dt0 = jnp.exp(jax.random.uniform(ks[13], (DEPTH, N_HEADS), jnp.float32, np.log(1e-3), np.log(1e-1)))
    return {
        "x_prompt": nrm(ks[0], (BATCH, SEQ, D_MODEL), 1.0),
        "x_sample": nrm(ks[1], (DEC_BATCH, DEC_SEQ, D_MODEL), 1.0),
        "state_pool": nrm(ks[2], (DEPTH, DEC_BATCH, POOL_BUF, D_POOL), 1.0),
        "state_conv": nrm(ks[3], (DEPTH, DEC_BATCH, CONV_W - 1, D_XBC), 1.0),
        "state_ssm": nrm(ks[4], (DEPTH, DEC_BATCH, N_HEADS, HEAD_DIM, D_STATE), 0.5),
        "c_prompt": nrm(ks[5], (BATCH, D_MODEL), 1.0),
        "c_sample": nrm(ks[6], (DEC_BATCH, D_MODEL), 1.0),
        "w_ada": nrm(ks[7], (DEPTH, D_MODEL, 3 * D_MODEL), 0.5 * D_MODEL ** -0.5),
        "b_ada": nrm(ks[8], (DEPTH, 3 * D_MODEL), 0.02),
        "norm_g": 1.0 + nrm(ks[9], (DEPTH, D_MODEL), 0.05),
        "w_in": nrm(ks[10], (DEPTH, D_MODEL, IN_COLS), D_MODEL ** -0.5),
        "conv_w": nrm(ks[11], (DEPTH, CONV_W, D_XBC), CONV_W ** -0.5),
        "conv_b": nrm(ks[12], (DEPTH, D_XBC), 0.02),
        "dt_bias": dt0 + jnp.log(-jnp.expm1(-dt0)),
        "a_log": jnp.log(jax.random.uniform(ks[14], (DEPTH, N_HEADS), jnp.float32, 1.0, 16.0)),
        "d_skip": 1.0 + nrm(ks[15], (DEPTH, N_HEADS), 0.1),
        "ssm_norm_g": 1.0 + nrm(ks[16], (DEPTH, D_INNER), 0.05),
        "pool_w": nrm(ks[17], (DEPTH, N_POOL_GROUPS, POOL_GROUP, POOL_GROUP), POOL_GROUP ** -0.5),
        "pool_scale": 1.0 + nrm(ks[18], (DEPTH, D_POOL), 0.1),
        "w_pool_out": nrm(ks[19], (DEPTH, D_POOL, D_MODEL), D_POOL ** -0.5),
        "w_ssm_out": nrm(ks[20], (DEPTH, D_INNER, D_MODEL), D_INNER ** -0.5),
        "w_o": nrm(ks[21], (DEPTH, D_MODEL, D_MODEL), D_MODEL ** -0.5),
        "final_g": 1.0 + nrm(ks[22], (D_MODEL,), 0.05),
    }


def reference(x_prompt, x_sample, state_pool, state_conv, state_ssm, c_prompt, c_sample,
              w_ada, b_ada, norm_g, w_in, conv_w, conv_b, dt_bias, a_log, d_skip, ssm_norm_g,
              pool_w, pool_scale, w_pool_out, w_ssm_out, w_o, final_g):
    bp = x_prompt.shape[0]
    xp, xs = x_prompt, x_sample
    pp, cp, sp, ps, cs, ss = [], [], [], [], [], []
    for l in range(DEPTH):
        wl = (w_ada[l], b_ada[l], norm_g[l], w_in[l], conv_w[l], conv_b[l], dt_bias[l], a_log[l],
              d_skip[l], ssm_norm_g[l], pool_w[l], pool_scale[l], w_pool_out[l], w_ssm_out[l], w_o[l])
        xp, p_new, c_new, s_new = layer(
            xp, c_prompt, 0,
            jnp.zeros((bp, POOL_BUF, D_POOL), xp.dtype),
            jnp.zeros((bp, CONV_W - 1, D_XBC), xp.dtype),
            jnp.zeros((bp, N_HEADS, HEAD_DIM, D_STATE), jnp.float32), *wl)
        pp.append(p_new); cp.append(c_new); sp.append(s_new)
        xs, p_new, c_new, s_new = layer(xs, c_sample, PAST_LEN, state_pool[l], state_conv[l], state_ssm[l], *wl)
        ps.append(p_new); cs.append(c_new); ss.append(s_new)
    y_prompt = rmsnorm(xp, final_g)
    y_sample = rmsnorm(xs, final_g)
    return (y_prompt, y_sample, jnp.stack(pp), jnp.stack(cp), jnp.stack(sp),
            jnp.stack(ps), jnp.stack(cs), jnp.stack(ss))
```

```cpp
#include <hip/hip_runtime.h>
#include <hip/hip_cooperative_groups.h>
#include <cstdio>
#include <cstdint>
namespace cg = cooperative_groups;

#define LAS __attribute__((address_space(3)))
typedef unsigned short bf16_t;
typedef short bf16x8 __attribute__((ext_vector_type(8)));
typedef float f32x4 __attribute__((ext_vector_type(4)));
typedef unsigned u32x4 __attribute__((ext_vector_type(4)));
typedef unsigned u32x2 __attribute__((ext_vector_type(2)));

constexpr int TP = 16384, TS = 1024, MT = TP + TS;
constexpr int NPROJ = 8192;
constexpr int NGEMM = 8448;
constexpr int C_U = 0, C_ZP = 512, C_ZS = 1024, C_XBC = 3072, C_GP = 6144, C_GS = 7168;
constexpr float EPS = 1e-6f;
constexpr size_t O_YP = 0, O_YS = 16777216, O_POOLP = 17825792, O_CONVP = 17887232, O_SSMP = 17960960, O_POOLS = 20058112, O_CONVS = 21041152, O_SSMS = 22220800;
constexpr size_t MiB = 1u << 20;
constexpr size_t WS_MODP = 1 * MiB;
constexpr size_t WS_WIN = 8 * MiB;
constexpr size_t WS_H = 26 * MiB;
constexpr size_t WS_XC = 1 * MiB;
constexpr size_t WS_XBS = 18 * MiB;
constexpr size_t WS_GB = 19 * MiB;
constexpr size_t WS_XT = 35 * MiB;
constexpr size_t WS_BT = 99 * MiB;
constexpr size_t WS_XS = 115 * MiB;
constexpr size_t WS_WP = 119 * MiB;
constexpr size_t WS_WS = 120 * MiB;
constexpr size_t WS_WO = 124 * MiB;
constexpr size_t WS_WPW = 126 * MiB;
constexpr size_t WS_DT = 127 * MiB;
constexpr size_t WS_SSQ = 130 * MiB;
constexpr size_t WS_SSP = 133 * MiB;
constexpr size_t WS_GATE = 135 * MiB;
constexpr size_t WS_ACS = 136 * MiB;
constexpr size_t WS_PM = 138 * MiB;
constexpr size_t WS_YZ = 155 * MiB;
constexpr size_t WS_PROJ = 223 * MiB;
constexpr size_t WS_END = 495 * MiB;
constexpr int LDS_BYTES = 160 * 1024;

struct Args { const float* in[23]; float* out; unsigned char* ws; int ph_lo, ph_hi; };

__device__ __forceinline__ unsigned cvt_pk_bf16(float lo, float hi) { unsigned r; asm volatile("v_cvt_pk_bf16_f32 %0, %1, %2" : "=v"(r) : "v"(lo), "v"(hi)); return r; }
__device__ __forceinline__ unsigned f2bf_c(float f) { unsigned u = __builtin_bit_cast(unsigned, f); return (u + 0x7fffu + ((u >> 16) & 1u)) >> 16; }
__device__ __forceinline__ unsigned pk2_c(float lo, float hi) { return f2bf_c(lo) | (f2bf_c(hi) << 16); }
__device__ __forceinline__ float bf_lo(unsigned u) { return __builtin_bit_cast(float, u << 16); }
__device__ __forceinline__ float bf_hi(unsigned u) { return __builtin_bit_cast(float, u & 0xffff0000u); }
__device__ __forceinline__ float bf2f(bf16_t u) { return __builtin_bit_cast(float, (unsigned)u << 16); }
__device__ __forceinline__ float wave_sum(float v) {
#pragma unroll
    for (int o = 1; o < 64; o <<= 1) v += __shfl_xor(v, o);
    return v;
}
__device__ __forceinline__ float sigmoidf_(float v) { return __builtin_amdgcn_rcpf(1.f + __expf(-v)); }
__device__ __forceinline__ float siluf_(float v) { return v * sigmoidf_(v); }
__device__ __forceinline__ void unpack8(u32x4 v, float* o) { o[0] = bf_lo(v.x); o[1] = bf_hi(v.x); o[2] = bf_lo(v.y); o[3] = bf_hi(v.y); o[4] = bf_lo(v.z); o[5] = bf_hi(v.z); o[6] = bf_lo(v.w); o[7] = bf_hi(v.w); }

namespace pg8 {
constexpr int BM = 256, BK = 64, HALF = 128, HTB = HALF * BK * 2, STAGE_BYTES = 8 * HTB, NXCD = 8, WGM = 8;
__host__ __device__ __forceinline__ int lds_byte(int r, int c) { const int st = (r >> 4) * 2 + (c >> 5), rr = r & 15, cc = c & 31, ob = rr * 64 + cc * 2; return st * 1024 + (ob ^ (((ob >> 9) & 1) << 5)); }
__host__ __device__ __forceinline__ void stage_rc(int b, int& R, int& C) { const int st = b / 1024, sb = b % 1024, swz = sb ^ (((sb >> 9) & 1) << 5); R = (st >> 1) * 16 + swz / 64; C = (st & 1) * 32 + (swz % 64) / 2; }
__host__ __device__ __forceinline__ int perm32(int rho) { const int n = rho >> 4, i = rho & 15; return 8 * (i >> 2) + 4 * n + (i & 3); }
struct Unit { int pm, pn; };
struct Gemm { const bf16_t* A; const bf16_t* Bt; int M, N, K; };
struct StaticOrder {
    int nM, nN, nwg, G, c;
    __host__ __device__ void init(int M, int N, int G_, int c_) { nM = M / BM; nN = N / BM; nwg = nM * nN; G = G_; c = c_; }
    __host__ __device__ bool next(int i, Unit& u) const {
        const long L = (long)i * G + c; if (L >= nwg) return false;
        int wgid = (int)L; { const int q = nwg / NXCD, r = nwg % NXCD, xcd = wgid % NXCD, off = wgid / NXCD; wgid = (xcd < r ? xcd * (q + 1) : r * (q + 1) + (xcd - r) * q) + off; }
        const int nig = WGM * nN, gid = wgid / nig, fm = gid * WGM, gsz = (nM - fm) < WGM ? (nM - fm) : WGM;
        u.pm = fm + ((wgid % nig) % gsz); u.pn = (wgid % nig) / gsz; return true;
    }
    __device__ __forceinline__ void a_ready(const Unit&) const {}
    __device__ __forceinline__ void done(const Unit&) const {}
};

template <class Epi, class Sched, bool ALIGN_EPI = false, bool SP2 = false>
__device__ __forceinline__ void gemm_phase(LAS unsigned char* lds, const Gemm g, const Sched& S, const Epi& E) {
    const int tid = threadIdx.x, wid = __builtin_amdgcn_readfirstlane(tid >> 6), lane = tid & 63, wr = wid >> 2, wc = wid & 3, fr = lane & 15, fq = lane >> 4;
    const int K = g.K, nt = K / BK;
    unsigned voffA[2], voffB[2];
#pragma unroll
    for (int i = 0; i < 2; ++i) { int R, C; stage_rc(tid * 16 + i * 8192, R, C); const int Rb = Epi::PERM ? ((R & ~31) + perm32(R & 31)) : R;
        voffA[i] = (unsigned)(R * K + C) * 2u; voffB[i] = (unsigned)(Rb * K + C) * 2u; }
    const size_t kstep = (size_t)(BK * 2);
    const size_t hstep = (size_t)HALF * K * 2;
    const size_t tstep = 2 * hstep;
    const unsigned ldsw = (unsigned)wid * 1024u;
    const int aoff = lds_byte(wr * 64 + fr, fq * 8), boff = lds_byte(wc * 32 + fr, fq * 8);
#define PG8_SA(b, h) (((b) * 2 + (h)) * HTB)
#define PG8_SB(b, h) ((4 + (b) * 2 + (h)) * HTB)
#define PG8_STAGE(bufoff, gbase, voff) do { _Pragma("unroll") for (int _i = 0; _i < 2; ++_i) \
        __builtin_amdgcn_global_load_lds((const unsigned*)((const char*)(gbase) + (voff)[_i]), (LAS unsigned*)(lds + (bufoff) + ldsw + _i * 8192), 16, 0, 0); } while (0)
#define PG8_LDA(dst, b, h) do { _Pragma("unroll") for (int m = 0; m < 4; ++m) _Pragma("unroll") for (int k = 0; k < 2; ++k) dst[m][k] = *(const LAS bf16x8*)(lds + PG8_SA(b, h) + aoff + m * 2048 + k * 1024); } while (0)
#define PG8_LDB(dst, b, h) do { _Pragma("unroll") for (int n = 0; n < 2; ++n) _Pragma("unroll") for (int k = 0; k < 2; ++k) dst[n][k] = *(const LAS bf16x8*)(lds + PG8_SB(b, h) + boff + n * 2048 + k * 1024); } while (0)
#define PG8_MMA(ai, bj, At, Bt) do { __builtin_amdgcn_s_setprio(1); _Pragma("unroll") for (int m = 0; m < 4; ++m) _Pragma("unroll") for (int n = 0; n < 2; ++n) _Pragma("unroll") for (int k = 0; k < 2; ++k) \
        acc[ai][bj][m][n] = __builtin_amdgcn_mfma_f32_16x16x32_bf16(Bt[n][k], At[m][k], acc[ai][bj][m][n], 0, 0, 0); __builtin_amdgcn_s_setprio(0); } while (0)
#define PG8_WAIT_V(n) asm volatile("s_waitcnt vmcnt(" #n ")" ::: "memory")
#define PG8_WAIT_L(n) asm volatile("s_waitcnt lgkmcnt(" #n ")" ::: "memory")
#define PG8_BAR __builtin_amdgcn_s_barrier()
#define PG8_SCHED __builtin_amdgcn_sched_barrier(0)
    Unit cur, nxt; int ui = 0;
    if (!S.next(0, cur)) return;
    f32x4 acc[2][2][4][2];
#pragma unroll
    for (int a = 0; a < 2; ++a)
#pragma unroll
        for (int b = 0; b < 2; ++b)
#pragma unroll
            for (int m = 0; m < 4; ++m)
#pragma unroll
                for (int n = 0; n < 2; ++n) acc[a][b][m][n] = (f32x4){0.f, 0.f, 0.f, 0.f};
    bf16x8 At[4][2], B0[2][2], B1[2][2];
    const char* cA = (const char*)g.A + (size_t)cur.pm * tstep; const char* cB = (const char*)g.Bt + (size_t)cur.pn * tstep;
    S.a_ready(cur);
    if constexpr (SP2) {
        PG8_STAGE(PG8_SB(0, 0), cB, voffB); PG8_STAGE(PG8_SB(0, 1), cB + hstep, voffB); PG8_STAGE(PG8_SA(0, 0), cA, voffA); PG8_STAGE(PG8_SA(0, 1), cA + hstep, voffA);
        if (wr == 1) PG8_BAR;
        PG8_WAIT_V(2); PG8_BAR;
        PG8_STAGE(PG8_SB(1, 0), cB + kstep, voffB); PG8_STAGE(PG8_SA(1, 0), cA + kstep, voffA); PG8_STAGE(PG8_SB(1, 1), cB + hstep + kstep, voffB);
        PG8_WAIT_V(6); PG8_BAR;
    } else {
        PG8_STAGE(PG8_SB(0, 0), cB, voffB); PG8_STAGE(PG8_SA(0, 0), cA, voffA); PG8_STAGE(PG8_SB(0, 1), cB + hstep, voffB); PG8_STAGE(PG8_SA(0, 1), cA + hstep, voffA);
        if (wr == 1) PG8_BAR;
        PG8_WAIT_V(4); PG8_BAR;
        PG8_STAGE(PG8_SB(1, 0), cB + kstep, voffB); PG8_STAGE(PG8_SA(1, 0), cA + kstep, voffA); PG8_STAGE(PG8_SB(1, 1), cB + hstep + kstep, voffB);
        PG8_WAIT_V(6); PG8_BAR;
    }
    for (;;) {
        const bool has_next = S.next(ui + 1, nxt);
        const char* nA = has_next ? (const char*)g.A + (size_t)nxt.pm * tstep : cA; const char* nB = has_next ? (const char*)g.Bt + (size_t)nxt.pn * tstep : cB;
        for (int t = 0; t < nt; t += 2) {
            const bool last = (t == nt - 2);
            const char* a1 = cA + (size_t)(t + 1) * kstep;
            const char* a2 = last ? nA : cA + (size_t)(t + 2) * kstep; const char* b2 = last ? nB : cB + (size_t)(t + 2) * kstep;
            const char* a3 = a2 + kstep; const char* b3 = b2 + kstep;
            if (last && has_next) S.a_ready(nxt);
            if constexpr (SP2) {
            PG8_LDB(B0, 0, 0); PG8_LDB(B1, 0, 1); PG8_SCHED; PG8_LDA(At, 0, 0); PG8_STAGE(PG8_SA(1, 1), a1 + hstep, voffA);
            PG8_WAIT_V(8); PG8_WAIT_L(0); PG8_BAR; PG8_MMA(0, 0, At, B0); PG8_MMA(0, 1, At, B1); PG8_BAR; PG8_SCHED;
            PG8_LDA(At, 0, 1); PG8_STAGE(PG8_SB(0, 0), b2, voffB); PG8_STAGE(PG8_SB(0, 1), b2 + hstep, voffB); PG8_STAGE(PG8_SA(0, 0), a2, voffA);
            PG8_WAIT_V(8); PG8_WAIT_L(0); PG8_BAR; PG8_MMA(1, 0, At, B0); PG8_MMA(1, 1, At, B1); PG8_BAR; PG8_SCHED;
            PG8_LDB(B0, 1, 0); PG8_LDB(B1, 1, 1); PG8_SCHED; PG8_LDA(At, 1, 0); PG8_STAGE(PG8_SA(0, 1), a2 + hstep, voffA);
            PG8_WAIT_V(8); PG8_WAIT_L(0); PG8_BAR; PG8_MMA(0, 0, At, B0); PG8_MMA(0, 1, At, B1); PG8_BAR; PG8_SCHED;
            PG8_LDA(At, 1, 1); PG8_STAGE(PG8_SB(1, 0), b3, voffB); PG8_STAGE(PG8_SB(1, 1), b3 + hstep, voffB); PG8_STAGE(PG8_SA(1, 0), a3, voffA);
            PG8_WAIT_V(8); PG8_WAIT_L(0); PG8_BAR; PG8_MMA(1, 0, At, B0); PG8_MMA(1, 1, At, B1); PG8_BAR; PG8_SCHED;
            } else {
            PG8_LDB(B0, 0, 0); PG8_SCHED; PG8_LDA(At, 0, 0); PG8_STAGE(PG8_SA(1, 1), a1 + hstep, voffA);
            PG8_WAIT_L(8); PG8_BAR; PG8_WAIT_L(0); PG8_MMA(0, 0, At, B0); PG8_BAR; PG8_SCHED;
            PG8_LDB(B1, 0, 1); PG8_STAGE(PG8_SB(0, 0), b2, voffB);
            PG8_BAR; PG8_WAIT_L(0); PG8_MMA(0, 1, At, B1); PG8_BAR;
            PG8_LDA(At, 0, 1); PG8_STAGE(PG8_SA(0, 0), a2, voffA);
            PG8_BAR; PG8_WAIT_L(0); PG8_MMA(1, 0, At, B0); PG8_BAR; PG8_SCHED;
            PG8_STAGE(PG8_SB(0, 1), b2 + hstep, voffB);
            PG8_WAIT_V(6); PG8_BAR; PG8_MMA(1, 1, At, B1); PG8_BAR;
            PG8_LDB(B0, 1, 0); PG8_SCHED; PG8_LDA(At, 1, 0); PG8_STAGE(PG8_SA(0, 1), a2 + hstep, voffA);
            PG8_WAIT_L(8); PG8_BAR; PG8_WAIT_L(0); PG8_MMA(0, 0, At, B0); PG8_BAR; PG8_SCHED;
            PG8_LDB(B1, 1, 1); PG8_STAGE(PG8_SB(1, 0), b3, voffB);
            PG8_BAR; PG8_WAIT_L(0); PG8_MMA(0, 1, At, B1); PG8_BAR;
            PG8_LDA(At, 1, 1); PG8_STAGE(PG8_SA(1, 0), a3, voffA);
            PG8_BAR; PG8_WAIT_L(0); PG8_MMA(1, 0, At, B0); PG8_BAR; PG8_SCHED;
            PG8_STAGE(PG8_SB(1, 1), b3 + hstep, voffB);
            PG8_WAIT_V(6); PG8_BAR; PG8_MMA(1, 1, At, B1); PG8_BAR;
            }
        }
        if constexpr (ALIGN_EPI) { if (wr == 0) PG8_BAR; }
        if constexpr (!Epi::AFTER_DRAIN) { E(acc, cur, wr, wc, fr, fq); S.done(cur); }
        if (!has_next) break;
#pragma unroll
        for (int a = 0; a < 2; ++a)
#pragma unroll
            for (int b = 0; b < 2; ++b)
#pragma unroll
                for (int m = 0; m < 4; ++m)
#pragma unroll
                    for (int n = 0; n < 2; ++n) acc[a][b][m][n] = (f32x4){0.f, 0.f, 0.f, 0.f};
        cur = nxt; cA = nA; cB = nB; ++ui;
        if constexpr (ALIGN_EPI) { if (wr == 1) PG8_BAR; }
    }
    PG8_WAIT_V(0);
    if constexpr (!ALIGN_EPI) { if (wr == 0) PG8_BAR; }
    PG8_BAR;
#undef PG8_SA
#undef PG8_SB
#undef PG8_STAGE
#undef PG8_LDA
#undef PG8_LDB
#undef PG8_MMA
#undef PG8_WAIT_V
#undef PG8_WAIT_L
#undef PG8_BAR
#undef PG8_SCHED
}

struct EpiProj {
    static constexpr bool PERM = true, AFTER_DRAIN = false;
    bf16_t* P; float* DT; const float* dt_bias;
    __device__ __forceinline__ void operator()(const f32x4 (&acc)[2][2][4][2], const Unit& u, int wr, int wc, int fr, int fq) const {
        const int row0 = u.pm * BM + wr * 64 + fr, pn = u.pn;
        if (pn < 32) {
            const int mode = (pn < 2) ? 0 : (pn < 12) ? 1 : (pn < 24) ? 0 : 2;
            const int col0 = pn * BM + wc * 32 + 8 * fq;
#pragma unroll
            for (int ai = 0; ai < 2; ++ai)
#pragma unroll
                for (int m = 0; m < 4; ++m) { bf16_t* rowp = P + (size_t)(row0 + ai * HALF + m * 16) * NPROJ + col0;
#pragma unroll
                    for (int bj = 0; bj < 2; ++bj) { f32x4 v0 = acc[ai][bj][m][0], v1 = acc[ai][bj][m][1];
                        if (mode == 1) {
#pragma unroll
                            for (int j = 0; j < 4; ++j) { v0[j] = siluf_(v0[j]); v1[j] = siluf_(v1[j]); } }
                        else if (mode == 2) {
#pragma unroll
                            for (int j = 0; j < 4; ++j) { v0[j] = sigmoidf_(v0[j]); v1[j] = sigmoidf_(v1[j]); } }
                        u32x4 w; w.x = cvt_pk_bf16(v0[0], v0[1]); w.y = cvt_pk_bf16(v0[2], v0[3]); w.z = cvt_pk_bf16(v1[0], v1[1]); w.w = cvt_pk_bf16(v1[2], v1[3]);
                        *(u32x4*)(rowp + bj * HALF) = w; } }
        } else if (wc == 0) {
            f32x4 bv[2];
#pragma unroll
            for (int n = 0; n < 2; ++n) bv[n] = *(const f32x4*)(dt_bias + 8 * fq + 4 * n);
#pragma unroll
            for (int ai = 0; ai < 2; ++ai)
#pragma unroll
                for (int m = 0; m < 4; ++m) { float* rowp = DT + (size_t)(row0 + ai * HALF + m * 16) * 32 + 8 * fq;
#pragma unroll
                    for (int n = 0; n < 2; ++n) { f32x4 v = acc[ai][0][m][n] + bv[n];
#pragma unroll
                        for (int j = 0; j < 4; ++j) { const float e = __expf(-fabsf(v[j]));
                            const float l = e < 0.0625f ? e * (1.f - e * (0.5f - e * (0.33333334f - e * (0.25f - 0.2f * e)))) : __logf(1.f + e); v[j] = fmaxf(v[j], 0.f) + l; }
                        *(f32x4*)(rowp + 4 * n) = v; } }
        }
    }
};
struct EpiPoolOut {
    static constexpr bool PERM = true, AFTER_DRAIN = false;
    const bf16_t* P; bf16_t* MB;
    __device__ __forceinline__ void operator()(const f32x4 (&acc)[2][2][4][2], const Unit& u, int wr, int wc, int fr, int fq) const {
        const int row0 = u.pm * BM + wr * 64 + fr, col0 = u.pn * BM + wc * 32 + 8 * fq;
#pragma unroll
        for (int ai = 0; ai < 2; ++ai)
#pragma unroll
            for (int m = 0; m < 4; ++m) { const size_t row = (size_t)(row0 + ai * HALF + m * 16);
#pragma unroll
                for (int bj = 0; bj < 2; ++bj) { const int col = col0 + bj * HALF;
                    float gt[8]; unpack8(*(const u32x4*)(P + row * NPROJ + C_GP + col), gt);
                    const f32x4 v0 = acc[ai][bj][m][0], v1 = acc[ai][bj][m][1];
                    u32x4 w; w.x = cvt_pk_bf16(v0[0] * gt[0], v0[1] * gt[1]); w.y = cvt_pk_bf16(v0[2] * gt[2], v0[3] * gt[3]); w.z = cvt_pk_bf16(v1[0] * gt[4], v1[1] * gt[5]); w.w = cvt_pk_bf16(v1[2] * gt[6], v1[3] * gt[7]);
                    *(u32x4*)(MB + row * 1024 + col) = w; } }
    }
};
struct EpiSsmOut {
    static constexpr bool PERM = true, AFTER_DRAIN = false;
    const bf16_t* P; bf16_t* MB; const LAS float* lr; int pm0;
    __device__ __forceinline__ void operator()(const f32x4 (&acc)[2][2][4][2], const Unit& u, int wr, int wc, int fr, int fq) const {
        const int row0 = u.pm * BM + wr * 64 + fr, col0 = u.pn * BM + wc * 32 + 8 * fq;
        const LAS float* lru = lr + (u.pm == pm0 ? 0 : 256) + wr * 64 + fr;
#pragma unroll
        for (int ai = 0; ai < 2; ++ai)
#pragma unroll
            for (int m = 0; m < 4; ++m) { const size_t row = (size_t)(row0 + ai * HALF + m * 16);
                const float rstd = lru[ai * HALF + m * 16];
#pragma unroll
                for (int bj = 0; bj < 2; ++bj) { const int col = col0 + bj * HALF;
                    float gt[8], mv[8]; unpack8(*(const u32x4*)(P + row * NPROJ + C_GS + col), gt); unpack8(*(const u32x4*)(MB + row * 1024 + col), mv);
                    const f32x4 v0 = acc[ai][bj][m][0] * rstd, v1 = acc[ai][bj][m][1] * rstd;
                    u32x4 w; w.x = cvt_pk_bf16(mv[0] + v0[0] * gt[0], mv[1] + v0[1] * gt[1]); w.y = cvt_pk_bf16(mv[2] + v0[2] * gt[2], mv[3] + v0[3] * gt[3]);
                    w.z = cvt_pk_bf16(mv[4] + v1[0] * gt[4], mv[5] + v1[1] * gt[5]); w.w = cvt_pk_bf16(mv[6] + v1[2] * gt[6], mv[7] + v1[3] * gt[7]);
                    *(u32x4*)(MB + row * 1024 + col) = w; } }
    }
};
struct EpiOut {
    static constexpr bool PERM = false, AFTER_DRAIN = false;
    const float* xp; const float* xs; const float* gatef; bf16_t* xb; float* ssp;
    __device__ __forceinline__ void operator()(const f32x4 (&acc)[2][2][4][2], const Unit& u, int wr, int wc, int fr, int fq) const {
        const int row0 = u.pm * BM + wr * 64 + fr, col0 = u.pn * BM + wc * 32 + 4 * fq;
        const bool prompt = u.pm < 64;
        f32x4 gh[2][2];
#pragma unroll
        for (int bj = 0; bj < 2; ++bj)
#pragma unroll
            for (int n = 0; n < 2; ++n) gh[bj][n] = *(const f32x4*)(gatef + (size_t)(prompt ? (u.pm >> 3) : 8) * 1024 + col0 + bj * HALF + n * 16);
#pragma unroll
        for (int ai = 0; ai < 2; ++ai)
#pragma unroll
            for (int m = 0; m < 4; ++m) { const int row = row0 + ai * HALF + m * 16;
                const int b = row < TP ? (row >> 11) : 8 + ((row - TP) >> 3);
                const float* xr = row < TP ? xp + (size_t)row * 1024 : xs + (size_t)(row - TP) * 1024;
                const float* gr = gatef + (size_t)b * 1024;
                float ss = 0.f;
#pragma unroll
                for (int bj = 0; bj < 2; ++bj)
#pragma unroll
                    for (int n = 0; n < 2; ++n) { const int col = col0 + bj * HALF + n * 16;
                        const f32x4 gv = prompt ? gh[bj][n] : *(const f32x4*)(gr + col);
                        const f32x4 o = *(const f32x4*)(xr + col) + gv * acc[ai][bj][m][n];
                        u32x2 w; w.x = cvt_pk_bf16(o[0], o[1]); w.y = cvt_pk_bf16(o[2], o[3]); *(u32x2*)(xb + (size_t)row * 1024 + col) = w;
                        ss += (o[0] * o[0] + o[1] * o[1]) + (o[2] * o[2] + o[3] * o[3]); }
                ss += __shfl_xor(ss, 16); ss += __shfl_xor(ss, 32);
                if (fq == 0) ssp[(size_t)row * 16 + u.pn * 4 + wc] = ss; }
    }
};
}

#define XB_TMO      128
#define XB_XCNT(j)  (256  + 64 * (j))
#define XB_XSUB(j)  (1280 + 64 * (j))
#define XB_XGEN(j)  (2304 + 64 * (j))
#define XB_TOP      3328
#define XB_TOPGEN   3392
#define XCD_BAR_WORDS 3456
#define XB_SPIN_CAP (1u << 18)

__device__ __forceinline__ unsigned xb_ld(unsigned* p)              { return __hip_atomic_load(p, __ATOMIC_RELAXED, __HIP_MEMORY_SCOPE_AGENT); }
__device__ __forceinline__ unsigned xb_add(unsigned* p, unsigned v) { return __hip_atomic_fetch_add(p, v, __ATOMIC_RELAXED, __HIP_MEMORY_SCOPE_AGENT); }
__device__ __forceinline__ unsigned xb_xcc_id() { return (unsigned)__builtin_amdgcn_s_getreg((3 << 11) | 20) & 0xFu; }
#define XB_SPIN(cond, bar) do { unsigned _sp = 0; while (cond) { __builtin_amdgcn_s_sleep(1); \
    if ((++_sp & 255u) == 0u) { if (xb_ld(&(bar)[XB_TMO])) break; if (_sp > XB_SPIN_CAP) { atomicAdd(&(bar)[XB_TMO], 1u); break; } } } } while (0)

struct XcdBarrier {
    unsigned* bar; unsigned x;
    volatile LAS unsigned* st;
};

__device__ __forceinline__ XcdBarrier xcd_barrier_post(unsigned* bar, volatile LAS unsigned* st) {
    XcdBarrier b; b.bar = bar; b.x = xb_xcc_id(); b.st = st;
    if (threadIdx.x == 0) (void)xb_add(&bar[XB_XCNT(b.x)], 1u);
    return b;
}
__device__ __forceinline__ void xcd_barrier_complete(unsigned* bar, unsigned x, unsigned& nloc, unsigned& nx) {
    const unsigned G = gridDim.x * gridDim.y * gridDim.z;
    unsigned sum, cnt, mine, sp = 0u;
    for (;;) {
        sum = 0u; cnt = 0u; mine = 0u;
#pragma unroll
        for (unsigned j = 0; j < 16; ++j) { const unsigned c = xb_ld(&bar[XB_XCNT(j)]); sum += c; cnt += (c > 0u) ? 1u : 0u; mine = (j == x) ? c : mine; }
        if (sum == G) break;
        __builtin_amdgcn_s_sleep(1);
        if ((++sp & 255u) == 0u) { if (xb_ld(&bar[XB_TMO])) break; if (sp > XB_SPIN_CAP) { atomicAdd(&bar[XB_TMO], 1u); break; } }
    }
    nloc = mine > 0u ? mine : 1u; nx = cnt > 0u ? cnt : 1u;
}

__device__ __forceinline__ void xcd_barrier(const XcdBarrier& b) {
    asm volatile("s_waitcnt vmcnt(0)" ::: "memory");
    __syncthreads();
    if (threadIdx.x == 0) {
        unsigned* bar = b.bar;
        __builtin_amdgcn_s_waitcnt(0);
        unsigned nloc = b.st[0], nx = b.st[1];
        if (nloc == 0u) { xcd_barrier_complete(bar, b.x, nloc, nx); b.st[0] = nloc; b.st[1] = nx; }
        const unsigned old = xb_add(&bar[XB_XSUB(b.x)], 1u);
        const unsigned gen = old / nloc;
        if (old + 1u == (gen + 1u) * nloc) {
            __builtin_amdgcn_fence(__ATOMIC_RELEASE, "agent");
            asm volatile("s_waitcnt vmcnt(0)" ::: "memory");
            const unsigned og = xb_add(&bar[XB_TOP], 1u);
            const unsigned tg = og / nx;
            if (og + 1u == (tg + 1u) * nx) xb_add(&bar[XB_TOPGEN], 1u);
            else XB_SPIN(xb_ld(&bar[XB_TOPGEN]) == tg, bar);
            __builtin_amdgcn_fence(__ATOMIC_ACQUIRE, "agent");
            xb_add(&bar[XB_XGEN(b.x)], 1u);
            asm volatile("s_waitcnt vmcnt(0)" ::: "memory");
        } else {
            XB_SPIN(xb_ld(&bar[XB_XGEN(b.x)]) == gen, bar);
            __builtin_amdgcn_fence(__ATOMIC_ACQUIRE, "agent");
            asm volatile("s_waitcnt vmcnt(0)" ::: "memory");
        }
    }
    __syncthreads();
}

constexpr int LSTR = 272;
constexpr int L_C = 0, L_B = 34816, L_BWT = 69632, L_XT = 104448, L_H = 121856, L_SC = 139264;
#define MFMA16(a, b, c) __builtin_amdgcn_mfma_f32_16x16x32_bf16(a, b, c, 0, 0, 0)

__device__ __forceinline__ void p0_transpose_item(const float* W, int K, int N, bf16_t* WT, int kb, int nb, int out_row0, LAS float* scr, int lane, const float* kscale) {
    const int k0 = 64 * kb, n0 = 32 * nb;
    float tv[32];
#pragma unroll
    for (int i = 0; i < 32; ++i) tv[i] = W[(size_t)(k0 + 2 * i + (lane >> 5)) * N + n0 + (lane & 31)];
#pragma unroll
    for (int i = 0; i < 32; ++i) { const int kk = 2 * i + (lane >> 5); float v = tv[i]; if (kscale) v *= kscale[k0 + kk]; scr[kk * 33 + (lane & 31)] = v; }
    asm volatile("s_waitcnt lgkmcnt(0)" ::: "memory");
    const int c = lane & 7;
#pragma unroll
    for (int j = 0; j < 4; ++j) { const int n = (lane >> 3) + 8 * j; const LAS float* s = scr + (8 * c) * 33 + n;
        u32x4 o; o.x = cvt_pk_bf16(s[0 * 33], s[1 * 33]); o.y = cvt_pk_bf16(s[2 * 33], s[3 * 33]); o.z = cvt_pk_bf16(s[4 * 33], s[5 * 33]); o.w = cvt_pk_bf16(s[6 * 33], s[7 * 33]);
        *(u32x4*)(WT + (size_t)(out_row0 + n) * K + k0 + 8 * c) = o; }
    asm volatile("s_waitcnt lgkmcnt(0)" ::: "memory");
}
__device__ __forceinline__ void phase0(const Args& a, LAS unsigned char* lds) {
    const int tid = threadIdx.x, lane = tid & 63, wave = tid >> 6, G = gridDim.x, bid = blockIdx.x;
    unsigned char* ws = a.ws;
    for (int item = bid; item < 192; item += G) {
        const int ks = item & 3, cs = (item >> 2) % 6, rg = item / 24;
        LAS float* sc = (LAS float*)lds;
        __syncthreads();
        for (int e = tid; e < 17 * 256; e += 512) { const int r = e >> 8, k = e & 255, row = rg * 17 + r;
            const float* cp = row < 8 ? a.in[5] + row * 1024 : a.in[6] + (row - 8) * 1024;
            const float v = cp[ks * 256 + k]; sc[e] = v / (1.f + __expf(-v)); }
        __syncthreads();
        const int col = cs * 512 + wave * 64 + lane;
        const float* wp = a.in[7] + (size_t)(ks * 256) * 3072 + col;
        float acc[17];
#pragma unroll
        for (int r = 0; r < 17; ++r) acc[r] = 0.f;
#pragma unroll 1
        for (int k16 = 0; k16 < 16; ++k16) {
            float w[16];
#pragma unroll
            for (int q = 0; q < 16; ++q) w[q] = wp[(size_t)(16 * k16 + q) * 3072];
#pragma unroll
            for (int q4 = 0; q4 < 4; ++q4) {
#pragma unroll
                for (int r = 0; r < 17; ++r) { const f32x4 s = *(const LAS f32x4*)(sc + r * 256 + 16 * k16 + 4 * q4); acc[r] += (s[0] * w[4 * q4] + s[1] * w[4 * q4 + 1]) + (s[2] * w[4 * q4 + 2] + s[3] * w[4 * q4 + 3]); } }
        }
        float* mp = (float*)(ws + WS_MODP) + ((size_t)ks * 136 + rg * 17) * 3072 + col;
#pragma unroll
        for (int r = 0; r < 17; ++r) mp[(size_t)r * 3072] = acc[r];
    }
    __syncthreads();
    { u32x4* z = (u32x4*)(ws + WS_WIN + (size_t)8224 * 1024 * 2); const u32x4 zero = (u32x4){0u, 0u, 0u, 0u};
      for (int e = bid * 512 + tid; e < 224 * 1024 * 2 / 16; e += G * 512) z[e] = zero; }
    LAS float* scr = (LAS float*)(lds + wave * 16384);
    const int tb0 = G > 224 ? 192 : 0;
    if (bid < tb0) return;
    const int gw = (bid - tb0) * 8 + wave, NGW = (G - tb0) * 8;
    constexpr int I_IN = 16 * 257, I_P = 8 * 32, I_S = 32 * 32, I_O = 16 * 32, I_PW = 4 * 8;
    for (int it = gw; it < I_IN + I_P + I_S + I_O + I_PW; it += NGW) {
        int r = it;
        if (r < I_IN) { const int kb = r / 257, nb = r % 257; const int orow = nb < 192 ? 32 * nb : (nb == 192 ? 8192 : 32 * nb - 32);
            p0_transpose_item(a.in[10], 1024, 8224, (bf16_t*)(ws + WS_WIN), kb, nb, orow, scr, lane, nullptr); continue; } r -= I_IN;
        if (r < I_P) { p0_transpose_item(a.in[19], 512, 1024, (bf16_t*)(ws + WS_WP), r / 32, r % 32, 32 * (r % 32), scr, lane, nullptr); continue; } r -= I_P;
        if (r < I_S) { p0_transpose_item(a.in[20], 2048, 1024, (bf16_t*)(ws + WS_WS), r / 32, r % 32, 32 * (r % 32), scr, lane, a.in[16]); continue; } r -= I_S;
        if (r < I_O) { p0_transpose_item(a.in[21], 1024, 1024, (bf16_t*)(ws + WS_WO), r / 32, r % 32, 32 * (r % 32), scr, lane, nullptr); continue; } r -= I_O;
        { const int g = r >> 3, q = r & 7; p0_transpose_item(a.in[17] + (size_t)g * 16384, 128, 128, (bf16_t*)(ws + WS_WPW) + (size_t)g * 16384, q >> 2, q & 3, 32 * (q & 3), scr, lane, nullptr); }
    }
}

__device__ __forceinline__ void phase1(const Args& a) {
    const int tid = threadIdx.x, lane = tid & 63, wave = tid >> 6, G = gridDim.x, bid = blockIdx.x;
    const int gw = bid * 8 + wave, NGW = G * 8;
    const float* modp = (const float*)(a.ws + WS_MODP); const float* b_ada = a.in[8]; const float* ng = a.in[9];
    bf16_t* H = (bf16_t*)(a.ws + WS_H);
    for (int grp = gw; grp < TP / 8; grp += NGW) {
        const int row0 = grp * 8; const int b = row0 < TP ? (row0 >> 11) : 8 + ((row0 - TP) >> 3);
        f32x4 gs[4], sh[4];
#pragma unroll
        for (int j = 0; j < 4; ++j) { const int k = 4 * lane + 256 * j;
            f32x4 shift = *(const f32x4*)(b_ada + k), scale = *(const f32x4*)(b_ada + 1024 + k);
#pragma unroll
            for (int ks = 0; ks < 4; ++ks) { const float* mp = modp + ((size_t)ks * 136 + b) * 3072 + k; shift += *(const f32x4*)mp; scale += *(const f32x4*)(mp + 1024); }
            gs[j] = *(const f32x4*)(ng + k) * (scale + 1.f); sh[j] = shift; }
#pragma unroll 1
        for (int r4 = 0; r4 < 8; r4 += 4) {
            f32x4 v[4][4];
#pragma unroll
            for (int u = 0; u < 4; ++u) { const int row = row0 + r4 + u; const float* xr = row < TP ? a.in[0] + (size_t)row * 1024 : a.in[1] + (size_t)(row - TP) * 1024;
#pragma unroll
                for (int j = 0; j < 4; ++j) v[u][j] = *(const f32x4*)(xr + 4 * lane + 256 * j); }
#pragma unroll
            for (int u = 0; u < 4; ++u) { const int row = row0 + r4 + u; float s = 0.f;
#pragma unroll
                for (int j = 0; j < 4; ++j) s += (v[u][j][0] * v[u][j][0] + v[u][j][1] * v[u][j][1]) + (v[u][j][2] * v[u][j][2] + v[u][j][3] * v[u][j][3]);
                const float rstd = rsqrtf(wave_sum(s) * (1.f / 1024.f) + EPS);
#pragma unroll
                for (int j = 0; j < 4; ++j) { const f32x4 o = v[u][j] * rstd * gs[j] + sh[j]; u32x2 w; w.x = cvt_pk_bf16(o[0], o[1]); w.y = cvt_pk_bf16(o[2], o[3]);
                    *(u32x2*)(H + (size_t)row * 1024 + 4 * lane + 256 * j) = w; } } }
    }
    for (int row = TP + gw; row < MT; row += NGW) {
        const int b = 8 + ((row - TP) >> 3); const float* xr = a.in[1] + (size_t)(row - TP) * 1024;
        f32x4 v[4]; float s = 0.f;
#pragma unroll
        for (int j = 0; j < 4; ++j) { v[j] = *(const f32x4*)(xr + 4 * lane + 256 * j); s += (v[j][0] * v[j][0] + v[j][1] * v[j][1]) + (v[j][2] * v[j][2] + v[j][3] * v[j][3]); }
        const float rstd = rsqrtf(wave_sum(s) * (1.f / 1024.f) + EPS);
#pragma unroll
        for (int j = 0; j < 4; ++j) { const int k = 4 * lane + 256 * j;
            f32x4 shift = *(const f32x4*)(b_ada + k), scale = *(const f32x4*)(b_ada + 1024 + k);
#pragma unroll
            for (int ks = 0; ks < 4; ++ks) { const float* mp = modp + ((size_t)ks * 136 + b) * 3072 + k; shift += *(const f32x4*)mp; scale += *(const f32x4*)(mp + 1024); }
            const f32x4 o = v[j] * rstd * (*(const f32x4*)(ng + k) * (scale + 1.f)) + shift; u32x2 w; w.x = cvt_pk_bf16(o[0], o[1]); w.y = cvt_pk_bf16(o[2], o[3]);
            *(u32x2*)(H + (size_t)row * 1024 + k) = w; }
    }
    float* gatef = (float*)(a.ws + WS_GATE);
    for (int e = bid * 512 + tid; e < 136 * 256; e += G * 512) { const int b = e >> 8, k = (e & 255) * 4;
        f32x4 gt = *(const f32x4*)(b_ada + 2048 + k);
#pragma unroll
        for (int ks = 0; ks < 4; ++ks) gt += *(const f32x4*)(modp + ((size_t)ks * 136 + b) * 3072 + 2048 + k);
        *(f32x4*)(gatef + (size_t)b * 1024 + k) = gt; }
}


__device__ __forceinline__ void p3_copies(const Args& a) {
    const int G = gridDim.x; const bf16_t* P = (const bf16_t*)(a.ws + WS_PROJ); float* out = a.out;
    const float* spool = a.in[2];
    const bool slack = (G == 256); if (slack && (blockIdx.x < 96 || blockIdx.x >= 224)) return;
    const int vb = slack ? (int)blockIdx.x - 96 : (int)blockIdx.x, NB = slack ? 128 : G;
    for (int w = vb * 512 + threadIdx.x; w < 2297856 / 8; w += NB * 512) {
        const int e = w * 8; const bf16_t* src = nullptr; const float* fsrc = nullptr; float* dst;
        if (e < 61440) { const int b = e / 7680, r = (e / 512) % 15, c = e & 511; src = P + (size_t)(b * 2048 + 2033 + r) * NPROJ + C_U + c; dst = out + O_POOLP + e; }
        else if (e < 61440 + 73728) { const int f = e - 61440, b = f / 9216, r = (f / 3072) % 3, c = f % 3072; src = P + (size_t)(b * 2048 + 2045 + r) * NPROJ + C_XBC + c; dst = out + O_CONVP + f; }
        else if (e < 61440 + 73728 + 983040) { const int f = e - 135168, b = f / 7680, r = (f / 512) % 15, c = f & 511; dst = out + O_POOLS + f;
            if (r < 7) fsrc = spool + (size_t)(b * 15 + 8 + r) * 512 + c; else src = P + (size_t)(TP + b * 8 + r - 7) * NPROJ + C_U + c; }
        else { const int f = e - 1118208, b = f / 9216, r = (f / 3072) % 3, c = f % 3072; src = P + (size_t)(TP + b * 8 + 5 + r) * NPROJ + C_XBC + c; dst = out + O_CONVS + f; }
        f32x4 o0, o1;
        if (fsrc) { o0 = *(const f32x4*)fsrc; o1 = *(const f32x4*)(fsrc + 4); }
        else { float u[8]; unpack8(*(const u32x4*)src, u); o0 = (f32x4){u[0], u[1], u[2], u[3]}; o1 = (f32x4){u[4], u[5], u[6], u[7]}; }
        *(f32x4*)dst = o0; *(f32x4*)(dst + 4) = o1;
    }
}

__device__ __forceinline__ void conv_prepass(const Args& a, LAS unsigned char* lds) {
    const int G = gridDim.x; const bf16_t* P = (const bf16_t*)(a.ws + WS_PROJ);
    bf16_t* XC = (bf16_t*)(a.ws + WS_XC); bf16_t* XBS = (bf16_t*)(a.ws + WS_XBS); bf16_t* XT = (bf16_t*)(a.ws + WS_XT); bf16_t* BT = (bf16_t*)(a.ws + WS_BT); bf16_t* XS = (bf16_t*)(a.ws + WS_XS);
    const float* convw = a.in[11]; const float* convb = a.in[12]; const float* sconv = a.in[3];
    for (int tile = blockIdx.x; tile < 136 * 12; tile += G) {
        const int ci = tile / 12, og = tile % 12; const bool samp = ci >= 128;
        const int l32 = threadIdx.x & 31, rl = threadIdx.x >> 5, gq = og - 8;
        const int oc = og < 8 ? og * 32 + l32 : (l32 < 16 ? 256 + gq * 16 + l32 : 320 + gq * 16 + (l32 - 16)), run = (samp ? ci - 128 : ci) * 16 + rl, xcol = oc * 8;
        float cw[4][8], cb[8];
#pragma unroll
        for (int k = 0; k < 4; ++k) { const f32x4 w0 = *(const f32x4*)(convw + k * 3072 + xcol), w1 = *(const f32x4*)(convw + k * 3072 + xcol + 4);
#pragma unroll
            for (int e = 0; e < 4; ++e) { cw[k][e] = w0[e]; cw[k][4 + e] = w1[e]; } }
        { const f32x4 b0 = *(const f32x4*)(convb + xcol), b1 = *(const f32x4*)(convb + xcol + 4);
#pragma unroll
          for (int e = 0; e < 4; ++e) { cb[e] = b0[e]; cb[4 + e] = b1[e]; } }
        const int R0 = samp ? TP + run * 8 : run * 8, pos0 = R0 & 2047;
        u32x4 rawp[11];
#pragma unroll
        for (int d = 0; d < 11; ++d) rawp[d] = (d >= 3 || (!samp && pos0 > 0)) ? *(const u32x4*)(P + (size_t)(R0 - 3 + d) * NPROJ + C_XBC + xcol) : (u32x4){0u, 0u, 0u, 0u};
        float hist[3][8];
#pragma unroll
        for (int d = 0; d < 3; ++d) {
            if (samp) { const float* sp = sconv + (size_t)(run * 3 + d) * 3072 + xcol; const f32x4 h0 = *(const f32x4*)sp, h1 = *(const f32x4*)(sp + 4);
#pragma unroll
                for (int e = 0; e < 4; ++e) { hist[d][e] = h0[e]; hist[d][4 + e] = h1[e]; } }
            else unpack8(rawp[d], hist[d]); }
        u32x4 nat[8]; float tv[8][8];
#pragma unroll
        for (int t = 0; t < 8; ++t) { float v[8];
#pragma unroll
            for (int e = 0; e < 8; ++e) v[e] = cb[e];
#pragma unroll
            for (int k = 0; k < 4; ++k) { float rw[8];
                if (t + k < 3) {
#pragma unroll
                    for (int e = 0; e < 8; ++e) rw[e] = hist[t + k][e]; }
                else unpack8(rawp[t + k], rw);
#pragma unroll
                for (int e = 0; e < 8; ++e) v[e] += cw[k][e] * rw[e]; }
#pragma unroll
            for (int e = 0; e < 8; ++e) { v[e] = siluf_(v[e]); tv[e][t] = v[e]; }
            nat[t].x = cvt_pk_bf16(v[0], v[1]); nat[t].y = cvt_pk_bf16(v[2], v[3]); nat[t].z = cvt_pk_bf16(v[4], v[5]); nat[t].w = cvt_pk_bf16(v[6], v[7]); }
        if (oc >= 256) {
            if (oc >= 320) {
#pragma unroll
                for (int t = 0; t < 8; ++t) *(u32x4*)(XC + (size_t)(R0 + t) * 512 + (oc - 320) * 8) = nat[t]; }
            else if (samp) {
#pragma unroll
                for (int t = 0; t < 8; ++t) *(u32x4*)(XBS + (size_t)(run * 8 + t) * 512 + (oc - 256) * 8) = nat[t]; }
            if (!samp) { const int base = l32 < 16 ? L_B + l32 * 16 : L_C + (l32 - 16) * 16;
#pragma unroll
                for (int t = 0; t < 8; ++t) *(LAS u32x4*)(lds + base + (rl * 8 + t) * LSTR) = nat[t]; } }
        else if (samp) {
#pragma unroll
            for (int t = 0; t < 8; ++t) *(u32x4*)(XS + (size_t)(run * 8 + t) * 2048 + xcol) = nat[t]; }
        if (!samp && oc < 320) {
            const int bc = R0 >> 7, j0 = R0 & 127;
            bf16_t* dst = oc < 256 ? XT + ((size_t)(bc * 32 + (oc >> 3)) * 64 + (oc & 7) * 8) * 128 + j0 : BT + ((size_t)(bc * 4 + ((oc - 256) >> 4)) * 128 + ((oc - 256) & 15) * 8) * 128 + j0;
#pragma unroll
            for (int e = 0; e < 8; ++e) { u32x4 w; w.x = cvt_pk_bf16(tv[e][0], tv[e][1]); w.y = cvt_pk_bf16(tv[e][2], tv[e][3]); w.z = cvt_pk_bf16(tv[e][4], tv[e][5]); w.w = cvt_pk_bf16(tv[e][6], tv[e][7]);
                *(u32x4*)(dst + (size_t)e * 128) = w; } }
        if (og >= 8 && !samp) {
            __syncthreads();
            const int lane = threadIdx.x & 63, wave = threadIdx.x >> 6, fr = lane & 15, fq = lane >> 4, wi = wave >> 1, wj = wave & 1, i0 = 32 * wi, jb0 = 64 * wj;
            f32x4 gacc[2][4];
#pragma unroll
            for (int mi = 0; mi < 2; ++mi)
#pragma unroll
                for (int nj = 0; nj < 4; ++nj) gacc[mi][nj] = (f32x4){0.f, 0.f, 0.f, 0.f};
#pragma unroll
            for (int ks = 0; ks < 4; ++ks) { bf16x8 af[2], bfr[4];
#pragma unroll
                for (int mi = 0; mi < 2; ++mi) af[mi] = *(const LAS bf16x8*)(lds + L_C + (i0 + 16 * mi + fr) * LSTR + ks * 64 + fq * 16);
#pragma unroll
                for (int nj = 0; nj < 4; ++nj) bfr[nj] = *(const LAS bf16x8*)(lds + L_B + (jb0 + 16 * nj + fr) * LSTR + ks * 64 + fq * 16);
#pragma unroll
                for (int mi = 0; mi < 2; ++mi)
#pragma unroll
                    for (int nj = 0; nj < 4; ++nj) gacc[mi][nj] = MFMA16(bfr[nj], af[mi], gacc[mi][nj]); }
            bf16_t* gb = (bf16_t*)(a.ws + WS_GB) + (size_t)(ci * 4 + gq) * 16384;
#pragma unroll
            for (int mi = 0; mi < 2; ++mi)
#pragma unroll
                for (int nj = 0; nj < 4; ++nj) { u32x2 w; w.x = pk2_c(gacc[mi][nj][0], gacc[mi][nj][1]); w.y = pk2_c(gacc[mi][nj][2], gacc[mi][nj][3]);
                    *(u32x2*)(gb + (size_t)(i0 + 16 * mi + fr) * 128 + jb0 + 16 * nj + 4 * fq) = w; }
            __syncthreads();
        }
    }
}
__device__ __forceinline__ void acs_prepass(const Args& a) {
    const int lane = threadIdx.x & 63, wave = threadIdx.x >> 6, G = gridDim.x;
    const bool slack = (G == 256);
    if (slack ? (wave >= 4 || blockIdx.x < 96 || blockIdx.x >= 224) : (wave >= 2)) return;
    const float* DT = (const float*)(a.ws + WS_DT); float* ACS = (float*)(a.ws + WS_ACS);
    const int h8 = lane & 7, seg = lane >> 3;
    for (int wi = slack ? ((int)blockIdx.x - 96) * 4 + wave : (int)blockIdx.x * 2 + wave; wi < 512; wi += slack ? 512 : G * 2) {
        const int ck = wi >> 2, head = (wi & 3) * 8 + h8; const float Aneg = -__expf(a.in[14][head]);
        const float* dp = DT + (size_t)(ck * 128 + 16 * seg) * 32 + head; float* ap = ACS + (size_t)(ck * 128 + 16 * seg) * 32 + head;
        float v[16]; float tot = 0.f;
#pragma unroll
        for (int t = 0; t < 16; ++t) v[t] = dp[t * 32];
#pragma unroll
        for (int t = 0; t < 16; ++t) { v[t] *= Aneg; tot += v[t]; }
        float pre = 0.f;
#pragma unroll
        for (int sgm = 0; sgm < 7; ++sgm) { const float ts = __shfl(tot, h8 + 8 * sgm); if (sgm < seg) pre += ts; }
        float run = pre;
#pragma unroll
        for (int t = 0; t < 16; ++t) { run += v[t]; ap[t * 32] = run; }
    }
}

__device__ __forceinline__ void ssd_prompt_item(const Args& a, LAS unsigned char* lds, int b, int head) {
    const int tid = threadIdx.x, lane = tid & 63, wave = tid >> 6, fr = lane & 15, fq = lane >> 4, g = head >> 3;
    const bf16_t* P = (const bf16_t*)(a.ws + WS_PROJ); const bf16_t* XC = (const bf16_t*)(a.ws + WS_XC); const bf16_t* XT = (const bf16_t*)(a.ws + WS_XT); const bf16_t* BT = (const bf16_t*)(a.ws + WS_BT); const bf16_t* GB = (const bf16_t*)(a.ws + WS_GB);
    const float* DT = (const float*)(a.ws + WS_DT); const float* ACS = (const float*)(a.ws + WS_ACS);
    bf16_t* YZ = (bf16_t*)(a.ws + WS_YZ); float* SSQ = (float*)(a.ws + WS_SSQ);
    const float Dsk = a.in[15][head];
    LAS float* sS = (LAS float*)(lds + L_SC);
    u32x4 pf[14]; u32x2 zf[4]; float pa = 0.f, pd = 0.f;
#define SSD_ISSUE(c_) do { const int R0n = b * 2048 + (c_) * 128, bcn = b * 16 + (c_); \
        if (tid < 128) { pa = ACS[(size_t)(R0n + tid) * 32 + head]; pd = DT[(size_t)(R0n + tid) * 32 + head]; } \
        _Pragma("unroll") for (int i = 0; i < 4; ++i) { const int q = tid + 512 * i; pf[i] = *(const u32x4*)(XC + (size_t)(R0n + (q >> 4)) * 512 + g * 128 + (q & 15) * 8); } \
        _Pragma("unroll") for (int i = 0; i < 4; ++i) { const int q = tid + 512 * i; pf[4 + i] = ((q & 15) * 8 <= (q >> 4)) ? *(const u32x4*)(GB + ((size_t)(bcn * 4 + g) * 128 + (q >> 4)) * 128 + (q & 15) * 8) : (u32x4){0u, 0u, 0u, 0u}; } \
        _Pragma("unroll") for (int i = 0; i < 4; ++i) { const int q = tid + 512 * i; pf[8 + i] = *(const u32x4*)(BT + ((size_t)(bcn * 4 + g) * 128 + (q >> 4)) * 128 + (q & 15) * 8); } \
        _Pragma("unroll") for (int i = 0; i < 2; ++i) { const int q = tid + 512 * i; pf[12 + i] = *(const u32x4*)(XT + ((size_t)(bcn * 32 + head) * 64 + (q >> 4)) * 128 + (q & 15) * 8); } } while (0)
#define SSD_ISSUE_Z(c_) do { const int R0n = b * 2048 + (c_) * 128; \
        _Pragma("unroll") for (int k = 0; k < 4; ++k) zf[k] = *(const u32x2*)(P + (size_t)(R0n + 16 * wave + fr) * NPROJ + C_ZS + head * 64 + 16 * k + 4 * fq); } while (0)
    __syncthreads();
    SSD_ISSUE(0); SSD_ISSUE_Z(0);
    for (int e = tid; e < 64 * LSTR / 16; e += 512) *(LAS u32x4*)(lds + L_H + e * 16) = (u32x4){0u, 0u, 0u, 0u};
    if (tid < 128) { sS[tid] = pa; sS[128 + tid] = pd; }
    __syncthreads();
    f32x4 hacc[4];
#pragma unroll
    for (int k = 0; k < 4; ++k) hacc[k] = (f32x4){0.f, 0.f, 0.f, 0.f};
#pragma unroll 1
    for (int c = 0; c < 16; ++c) {
        const int R0 = b * 2048 + c * 128;
        LAS float* sAcs = sS + (c & 1) * 256; LAS float* sDt = sAcs + 128;
        const float last = sAcs[127];
        { const int jo = tid & 15; float w8[8], aj[8], dj[8];
          { const f32x4 a0 = *(const LAS f32x4*)(sAcs + jo * 8), a1 = *(const LAS f32x4*)(sAcs + jo * 8 + 4), d0 = *(const LAS f32x4*)(sDt + jo * 8), d1 = *(const LAS f32x4*)(sDt + jo * 8 + 4);
#pragma unroll
            for (int e = 0; e < 4; ++e) { aj[e] = a0[e]; aj[4 + e] = a1[e]; dj[e] = d0[e]; dj[4 + e] = d1[e]; }
#pragma unroll
            for (int e = 0; e < 8; ++e) w8[e] = __expf(last - aj[e]) * dj[e]; }
#pragma unroll
          for (int i = 0; i < 4; ++i) { const int q = tid + 512 * i, ii = q >> 4, off = ii * LSTR + jo * 16;
              *(LAS u32x4*)(lds + L_C + off) = pf[i];
              { float gv[8]; unpack8(pf[4 + i], gv); const float ai = sAcs[ii]; float at[8];
#pragma unroll
                for (int e = 0; e < 8; ++e) { const float v = gv[e] * __expf(fminf(ai - aj[e], 0.f)) * dj[e]; at[e] = (jo * 8 + e <= ii) ? v : 0.f; }
                u32x4 w; w.x = cvt_pk_bf16(at[0], at[1]); w.y = cvt_pk_bf16(at[2], at[3]); w.z = cvt_pk_bf16(at[4], at[5]); w.w = cvt_pk_bf16(at[6], at[7]);
                *(LAS u32x4*)(lds + L_B + off) = w; }
              float bv[8]; unpack8(pf[8 + i], bv); u32x4 w; w.x = cvt_pk_bf16(bv[0] * w8[0], bv[1] * w8[1]); w.y = cvt_pk_bf16(bv[2] * w8[2], bv[3] * w8[3]); w.z = cvt_pk_bf16(bv[4] * w8[4], bv[5] * w8[5]); w.w = cvt_pk_bf16(bv[6] * w8[6], bv[7] * w8[7]);
              *(LAS u32x4*)(lds + L_BWT + off) = w; }
#pragma unroll
          for (int i = 0; i < 2; ++i) { const int q = tid + 512 * i; *(LAS u32x4*)(lds + L_XT + (q >> 4) * LSTR + jo * 16) = pf[12 + i]; } }
        if (c + 1 < 16) SSD_ISSUE(c + 1);
        __syncthreads();
        const int irow = 16 * wave + fr;
        f32x4 yacc[4];
#pragma unroll
        for (int k = 0; k < 4; ++k) yacc[k] = (f32x4){0.f, 0.f, 0.f, 0.f};
#pragma unroll
        for (int ks = 0; ks < 4; ++ks) { const bf16x8 cf = *(const LAS bf16x8*)(lds + L_C + irow * LSTR + ks * 64 + fq * 16);
#pragma unroll
            for (int k = 0; k < 4; ++k) { const bf16x8 hf = *(const LAS bf16x8*)(lds + L_H + (16 * k + fr) * LSTR + ks * 64 + fq * 16); yacc[k] = MFMA16(hf, cf, yacc[k]); } }
        { const float ea = __expf(sAcs[irow]), dec = __expf(last);
#pragma unroll
          for (int k = 0; k < 4; ++k) { yacc[k] *= ea; hacc[k] *= dec; } }
#pragma unroll
        for (int ks = 0; ks < 4; ++ks) { const bf16x8 af = *(const LAS bf16x8*)(lds + L_B + irow * LSTR + ks * 64 + fq * 16);
            const bf16x8 bwf = *(const LAS bf16x8*)(lds + L_BWT + irow * LSTR + ks * 64 + fq * 16);
#pragma unroll
            for (int k = 0; k < 4; ++k) { const bf16x8 xf = *(const LAS bf16x8*)(lds + L_XT + (16 * k + fr) * LSTR + ks * 64 + fq * 16);
                yacc[k] = MFMA16(xf, af, yacc[k]); hacc[k] = MFMA16(xf, bwf, hacc[k]); } }
        { const size_t row = (size_t)(R0 + irow); float ssq = 0.f;
#pragma unroll
          for (int k = 0; k < 4; ++k) { const int p0 = 16 * k + 4 * fq; const u32x2 zz = zf[k];
              float yz[4];
#pragma unroll
              for (int r = 0; r < 4; ++r) { const float xv = bf2f(*(const LAS unsigned short*)(lds + L_XT + (p0 + r) * LSTR + irow * 2));
                  const float z = r == 0 ? bf_lo(zz.x) : r == 1 ? bf_hi(zz.x) : r == 2 ? bf_lo(zz.y) : bf_hi(zz.y);
                  yz[r] = (yacc[k][r] + Dsk * xv) * z; ssq += yz[r] * yz[r]; }
              u32x2 w; w.x = cvt_pk_bf16(yz[0], yz[1]); w.y = cvt_pk_bf16(yz[2], yz[3]);
              *(u32x2*)(YZ + row * 2048 + head * 64 + p0) = w; }
          ssq += __shfl_xor(ssq, 16); ssq += __shfl_xor(ssq, 32);
          if (fq == 0) SSQ[row * 32 + head] = ssq; }
        if (c + 1 < 16) SSD_ISSUE_Z(c + 1);
        if (tid < 128 && c + 1 < 16) { LAS float* nS = sS + ((c + 1) & 1) * 256; nS[tid] = pa; nS[128 + tid] = pd; }
        __syncthreads();
#pragma unroll
        for (int k = 0; k < 4; ++k)
#pragma unroll
            for (int r = 0; r < 4; ++r) *(LAS unsigned short*)(lds + L_H + (16 * k + 4 * fq + r) * LSTR + (16 * wave + fr) * 2) = (unsigned short)(cvt_pk_bf16(hacc[k][r], 0.f) & 0xffffu);
    }
#undef SSD_ISSUE
#undef SSD_ISSUE_Z
    float* so = a.out + O_SSMP + (size_t)(b * 32 + head) * 8192;
#pragma unroll
    for (int k = 0; k < 4; ++k)
#pragma unroll
        for (int r = 0; r < 4; ++r) so[(16 * k + 4 * fq + r) * 128 + 16 * wave + fr] = hacc[k][r];
}

#define WAVE_LDS_SYNC() asm volatile("s_waitcnt lgkmcnt(0)" ::: "memory")
__device__ __forceinline__ void ssd_sample_items(const Args& a, LAS unsigned char* lds) {
    const int tid = threadIdx.x, lane = tid & 63, wave = tid >> 6, fr = lane & 15, fq = lane >> 4, G = gridDim.x;
    const bf16_t* P = (const bf16_t*)(a.ws + WS_PROJ); const bf16_t* XC = (const bf16_t*)(a.ws + WS_XC); const bf16_t* XBS = (const bf16_t*)(a.ws + WS_XBS); const bf16_t* XS = (const bf16_t*)(a.ws + WS_XS); const float* DT = (const float*)(a.ws + WS_DT);
    bf16_t* YZ = (bf16_t*)(a.ws + WS_YZ); float* SSQ = (float*)(a.ws + WS_SSQ); const float* sssm = a.in[4];
    LAS float* sxw = (LAS float*)(lds + wave * 9216); LAS float* sbw = sxw + 512; LAS float* satt = sbw + 1024; LAS float* sy = satt + 64;
    const int jx = lane >> 3, ox = lane & 7, tf = fr & 7;
    __syncthreads();
#pragma unroll 1
    for (int item = blockIdx.x * 8 + wave; item < 4096; item += G * 8) {
        const int bb = item >> 5, head = item & 31, g = head >> 3, R0 = TP + bb * 8;
        const float* hp = sssm + (size_t)item * 8192; float* so = a.out + O_SSMS + (size_t)item * 8192;
        f32x4 h[2][4][2];
#define SMP_LOAD_H(hh) do { _Pragma("unroll") for (int q = 0; q < 2; ++q) _Pragma("unroll") for (int ks = 0; ks < 4; ++ks) { \
            const float* p_ = hp + (16 * (2 * (hh) + q) + fr) * 128 + 32 * ks + 8 * fq; h[q][ks][0] = *(const f32x4*)p_; h[q][ks][1] = *(const f32x4*)(p_ + 4); } } while (0)
        SMP_LOAD_H(0);
        const float dtl = lane < 8 ? DT[(size_t)(R0 + lane) * 32 + head] : 0.f;
        const u32x4 xr = *(const u32x4*)(XS + (size_t)(bb * 8 + jx) * 2048 + head * 64 + ox * 8);
        const u32x4 zr = *(const u32x4*)(P + (size_t)(R0 + jx) * NPROJ + C_ZS + head * 64 + ox * 8);
        u32x4 br[2];
#pragma unroll
        for (int k = 0; k < 2; ++k) { const int piece = lane + 64 * k; br[k] = *(const u32x4*)(XBS + (size_t)(bb * 8 + (piece >> 4)) * 512 + g * 128 + (piece & 15) * 8); }
        bf16x8 cfr[4], bfr[4];
#pragma unroll
        for (int ks = 0; ks < 4; ++ks) { cfr[ks] = *(const bf16x8*)(XC + (size_t)(R0 + tf) * 512 + g * 128 + 32 * ks + 8 * fq); bfr[ks] = *(const bf16x8*)(XBS + (size_t)(bb * 8 + tf) * 512 + g * 128 + 32 * ks + 8 * fq); }
        const float Aneg = -__expf(a.in[14][head]), Dsk = a.in[15][head];
        float acs[8], dtv[8]; float run = 0.f;
#pragma unroll
        for (int t = 0; t < 8; ++t) { dtv[t] = __builtin_bit_cast(float, __builtin_amdgcn_readlane(__builtin_bit_cast(int, dtl), t)); run += dtv[t] * Aneg; acs[t] = run; }
        const float last = run, dec = __expf(last);
        float acsl = 0.f, wl = 0.f;
#pragma unroll
        for (int t = 0; t < 8; ++t) if (lane == t) { acsl = acs[t]; wl = __expf(last - acs[t]) * dtv[t]; }
        { float xv[8]; unpack8(xr, xv);
          *(LAS f32x4*)(sxw + jx * 64 + ox * 8) = (f32x4){xv[0], xv[1], xv[2], xv[3]}; *(LAS f32x4*)(sxw + jx * 64 + ox * 8 + 4) = (f32x4){xv[4], xv[5], xv[6], xv[7]}; }
#pragma unroll
        for (int k = 0; k < 2; ++k) { const int piece = lane + 64 * k, j = piece >> 4, oct = piece & 15; const float wj = __shfl(wl, j); float bv[8]; unpack8(br[k], bv);
            *(LAS f32x4*)(sbw + j * 128 + oct * 8) = (f32x4){bv[0] * wj, bv[1] * wj, bv[2] * wj, bv[3] * wj}; *(LAS f32x4*)(sbw + j * 128 + oct * 8 + 4) = (f32x4){bv[4] * wj, bv[5] * wj, bv[6] * wj, bv[7] * wj}; }
        f32x4 gacc = (f32x4){0.f, 0.f, 0.f, 0.f};
#pragma unroll
        for (int ks = 0; ks < 4; ++ks) gacc = MFMA16(cfr[ks], bfr[ks], gacc);
        float ea[4];
        { const float aj = __shfl(acsl, tf), dj = __shfl(dtl, tf);
#pragma unroll
          for (int r = 0; r < 4; ++r) { const int i = (4 * fq + r) & 7; const float ai = __shfl(acsl, i); ea[r] = __expf(ai);
              const float val = (fr <= i) ? gacc[r] * __expf(ai - aj) * dj : 0.f;
              if (fq < 2 && fr < 8) satt[i * 8 + fr] = val; } }
        WAVE_LDS_SYNC();
#define SMP_PROCESS_H(hh) do { \
        f32x4 yacc[2]; yacc[0] = (f32x4){0.f, 0.f, 0.f, 0.f}; yacc[1] = yacc[0]; \
        _Pragma("unroll") for (int ks = 0; ks < 4; ++ks) _Pragma("unroll") for (int q = 0; q < 2; ++q) { u32x4 hw; hw.x = cvt_pk_bf16(h[q][ks][0][0], h[q][ks][0][1]); hw.y = cvt_pk_bf16(h[q][ks][0][2], h[q][ks][0][3]); \
                hw.z = cvt_pk_bf16(h[q][ks][1][0], h[q][ks][1][1]); hw.w = cvt_pk_bf16(h[q][ks][1][2], h[q][ks][1][3]); \
                yacc[q] = MFMA16(cfr[ks], __builtin_bit_cast(bf16x8, hw), yacc[q]); } \
        if (fq < 2) { _Pragma("unroll") for (int r = 0; r < 4; ++r) { const int i = 4 * fq + r; \
                _Pragma("unroll") for (int q = 0; q < 2; ++q) { const int p = 16 * (2 * (hh) + q) + fr; float y = ea[r] * yacc[q][r]; \
                    _Pragma("unroll") for (int j = 0; j < 8; ++j) y += satt[i * 8 + j] * sxw[j * 64 + p]; \
                    y += Dsk * sxw[i * 64 + p]; sy[i * 64 + p] = y; } } } \
        _Pragma("unroll") for (int ks = 0; ks < 4; ++ks) { \
            _Pragma("unroll") for (int q = 0; q < 2; ++q) { h[q][ks][0] *= dec; h[q][ks][1] *= dec; } \
            _Pragma("unroll") for (int jh = 0; jh < 2; ++jh) { f32x4 bw[4][2]; \
                _Pragma("unroll") for (int jj = 0; jj < 4; ++jj) { bw[jj][0] = *(const LAS f32x4*)(sbw + (4 * jh + jj) * 128 + 32 * ks + 8 * fq); bw[jj][1] = *(const LAS f32x4*)(sbw + (4 * jh + jj) * 128 + 32 * ks + 8 * fq + 4); } \
                _Pragma("unroll") for (int q = 0; q < 2; ++q) _Pragma("unroll") for (int jj = 0; jj < 4; ++jj) { const float xs = sxw[(4 * jh + jj) * 64 + 16 * (2 * (hh) + q) + fr]; h[q][ks][0] += bw[jj][0] * xs; h[q][ks][1] += bw[jj][1] * xs; } } \
            _Pragma("unroll") for (int q = 0; q < 2; ++q) { float* p_ = so + (16 * (2 * (hh) + q) + fr) * 128 + 32 * ks + 8 * fq; *(f32x4*)p_ = h[q][ks][0]; *(f32x4*)(p_ + 4) = h[q][ks][1]; } } } while (0)
        SMP_PROCESS_H(0);
        SMP_LOAD_H(1);
        SMP_PROCESS_H(1);
#undef SMP_LOAD_H
#undef SMP_PROCESS_H
        WAVE_LDS_SYNC();
        { const f32x4 y0 = *(const LAS f32x4*)(sy + jx * 64 + ox * 8), y1 = *(const LAS f32x4*)(sy + jx * 64 + ox * 8 + 4); float zv[8]; unpack8(zr, zv);
          const float q0 = y0[0] * zv[0], q1 = y0[1] * zv[1], q2 = y0[2] * zv[2], q3 = y0[3] * zv[3], q4 = y1[0] * zv[4], q5 = y1[1] * zv[5], q6 = y1[2] * zv[6], q7 = y1[3] * zv[7];
          u32x4 w; w.x = cvt_pk_bf16(q0, q1); w.y = cvt_pk_bf16(q2, q3); w.z = cvt_pk_bf16(q4, q5); w.w = cvt_pk_bf16(q6, q7);
          *(u32x4*)(YZ + (size_t)(R0 + jx) * 2048 + head * 64 + ox * 8) = w;
          float ssq = ((q0 * q0 + q1 * q1) + (q2 * q2 + q3 * q3)) + ((q4 * q4 + q5 * q5) + (q6 * q6 + q7 * q7));
          ssq += __shfl_xor(ssq, 1); ssq += __shfl_xor(ssq, 2); ssq += __shfl_xor(ssq, 4);
          if (ox == 0) SSQ[(size_t)(R0 + jx) * 32 + head] = ssq; }
        WAVE_LDS_SYNC();
    }
}

template <int W> __device__ __forceinline__ void pool_d4(const bf16_t* P, const float* spool, int row0, int ccol, float (&dd)[4][8]) {
    float sum[4][8], uu[4][8];
#pragma unroll
    for (int tk = 0; tk < 4; ++tk)
#pragma unroll
        for (int e = 0; e < 8; ++e) sum[tk][e] = 0.f;
    if (row0 < TP) { const int pos0 = row0 & 2047;
        u32x4 rv[W + 3];
#pragma unroll
        for (int d = 0; d < W + 3; ++d) { const int off = d - (W - 1); rv[d] = (pos0 + off >= 0) ? *(const u32x4*)(P + (size_t)(row0 + off) * NPROJ + C_U + ccol) : (u32x4){0u, 0u, 0u, 0u}; }
#pragma unroll
        for (int d = 0; d < W + 3; ++d) { float u[8]; unpack8(rv[d], u);
#pragma unroll
            for (int tk = 0; tk < 4; ++tk) if (d >= tk && d <= tk + W - 1) {
#pragma unroll
                for (int e = 0; e < 8; ++e) sum[tk][e] += u[e];
                if (d == tk + W - 1) {
#pragma unroll
                    for (int e = 0; e < 8; ++e) uu[tk][e] = u[e]; } } }
#pragma unroll
        for (int tk = 0; tk < 4; ++tk) { const int cnt = pos0 + tk + 1 < W ? pos0 + tk + 1 : W; const float inv = 1.f / (float)cnt;
#pragma unroll
            for (int e = 0; e < 8; ++e) dd[tk][e] = sum[tk][e] * inv - uu[tk][e]; } }
    else { const int rr = row0 - TP, bb = rr >> 3, tt0 = rr & 7;
#pragma unroll
        for (int d = 0; d < W + 3; ++d) { const int s_ = tt0 - (W - 1) + d;
            float u[8];
            if (s_ >= 0) unpack8(*(const u32x4*)(P + (size_t)(TP + bb * 8 + s_) * NPROJ + C_U + ccol), u);
            else { const float* sp = spool + (size_t)(bb * 15 + 15 + s_) * 512 + ccol; const f32x4 u0 = *(const f32x4*)sp, u1 = *(const f32x4*)(sp + 4);
#pragma unroll
                for (int e = 0; e < 4; ++e) { u[e] = u0[e]; u[4 + e] = u1[e]; } }
#pragma unroll
            for (int tk = 0; tk < 4; ++tk) if (d >= tk && d <= tk + W - 1) {
#pragma unroll
                for (int e = 0; e < 8; ++e) sum[tk][e] += u[e];
                if (d == tk + W - 1) {
#pragma unroll
                    for (int e = 0; e < 8; ++e) uu[tk][e] = u[e]; } } }
        const float inv = 1.f / (float)W;
#pragma unroll
        for (int tk = 0; tk < 4; ++tk)
#pragma unroll
            for (int e = 0; e < 8; ++e) dd[tk][e] = sum[tk][e] * inv - uu[tk][e]; }
}
__device__ __forceinline__ void pool_items(const Args& a, LAS unsigned char* lds) {
    const int tid = threadIdx.x, lane = tid & 63, wave = tid >> 6, fr = lane & 15, fq = lane >> 4, G = gridDim.x;
    const bf16_t* P = (const bf16_t*)(a.ws + WS_PROJ); const bf16_t* WPW = (const bf16_t*)(a.ws + WS_WPW); bf16_t* PM = (bf16_t*)(a.ws + WS_PM);
    const float* spool = a.in[2]; const float* pscale = a.in[18];
    __syncthreads();
    for (int item = G - 1 - (int)blockIdx.x; item < 544; item += G) {
        const int grp = 3 - item / 136, tile = item % 136, R0 = tile * 128;
        { const int oc = tid & 15, t0 = (tid >> 4) * 4, ccol = grp * 128 + oc * 8; float dd[4][8];
          if (grp == 0) pool_d4<2>(P, spool, R0 + t0, ccol, dd); else if (grp == 1) pool_d4<4>(P, spool, R0 + t0, ccol, dd);
          else if (grp == 2) pool_d4<8>(P, spool, R0 + t0, ccol, dd); else pool_d4<16>(P, spool, R0 + t0, ccol, dd);
#pragma unroll
          for (int tk = 0; tk < 4; ++tk) { u32x4 wv; wv.x = cvt_pk_bf16(dd[tk][0], dd[tk][1]); wv.y = cvt_pk_bf16(dd[tk][2], dd[tk][3]); wv.z = cvt_pk_bf16(dd[tk][4], dd[tk][5]); wv.w = cvt_pk_bf16(dd[tk][6], dd[tk][7]);
              *(LAS u32x4*)(lds + (t0 + tk) * LSTR + oc * 16) = wv; } }
        bf16x8 wf[4][8];
#pragma unroll
        for (int ks = 0; ks < 4; ++ks)
#pragma unroll
            for (int nf = 0; nf < 8; ++nf) wf[ks][nf] = *(const bf16x8*)(WPW + ((size_t)(grp * 128 + 16 * nf + fr) * 128 + 32 * ks + 8 * fq));
        __syncthreads();
        f32x4 acc[8];
#pragma unroll
        for (int nf = 0; nf < 8; ++nf) acc[nf] = (f32x4){0.f, 0.f, 0.f, 0.f};
#pragma unroll
        for (int ks = 0; ks < 4; ++ks) { const bf16x8 df = *(const LAS bf16x8*)(lds + (16 * wave + fr) * LSTR + ks * 64 + fq * 16);
#pragma unroll
            for (int nf = 0; nf < 8; ++nf) acc[nf] = MFMA16(wf[ks][nf], df, acc[nf]); }
        { const size_t row = (size_t)(R0 + 16 * wave + fr);
#pragma unroll
          for (int nf = 0; nf < 8; ++nf) { const int dc = grp * 128 + 16 * nf + 4 * fq;
              const f32x4 sc = *(const f32x4*)(pscale + dc); const u32x2 zz = *(const u32x2*)(P + row * NPROJ + C_ZP + dc);
              u32x2 o; o.x = cvt_pk_bf16(acc[nf][0] * sc[0] * bf_lo(zz.x), acc[nf][1] * sc[1] * bf_hi(zz.x)); o.y = cvt_pk_bf16(acc[nf][2] * sc[2] * bf_lo(zz.y), acc[nf][3] * sc[3] * bf_hi(zz.y));
              *(u32x2*)(PM + row * 512 + dc) = o; } }
        __syncthreads();
    }
}

__device__ __forceinline__ void phase6(const Args& a) {
    const int tid = threadIdx.x, lane = tid & 63, wave = tid >> 6, G = gridDim.x;
    const float* ssp = (const float*)(a.ws + WS_SSP); const float* fg = a.in[22]; const bf16_t* xb = (const bf16_t*)(a.ws + WS_YZ);
    f32x4 gv[4];
#pragma unroll
    for (int j = 0; j < 4; ++j) gv[j] = *(const f32x4*)(fg + 4 * lane + 256 * j);
    for (int r0 = (blockIdx.x * 8 + wave) * 4; r0 < TP; r0 += G * 32) {
        float sv[4]; f32x4 v[4][4];
#pragma unroll
        for (int u = 0; u < 4; ++u) { sv[u] = lane < 16 ? ssp[(size_t)(r0 + u) * 16 + lane] : 0.f;
#pragma unroll
            for (int j = 0; j < 4; ++j) { const u32x2 w = *(const u32x2*)(xb + (size_t)(r0 + u) * 1024 + 4 * lane + 256 * j); v[u][j] = (f32x4){bf_lo(w.x), bf_hi(w.x), bf_lo(w.y), bf_hi(w.y)}; } }
#pragma unroll
        for (int u = 0; u < 4; ++u) { const float rstd = rsqrtf(wave_sum(sv[u]) * (1.f / 1024.f) + EPS);
#pragma unroll
            for (int j = 0; j < 4; ++j) *(f32x4*)(a.out + (size_t)(r0 + u) * 1024 + 4 * lane + 256 * j) = v[u][j] * rstd * gv[j]; }
    }
    for (int row = TP + blockIdx.x * 8 + wave; row < MT; row += G * 8) {
        const float sv = lane < 16 ? ssp[(size_t)row * 16 + lane] : 0.f; f32x4 v[4];
#pragma unroll
        for (int j = 0; j < 4; ++j) { const u32x2 w = *(const u32x2*)(xb + (size_t)row * 1024 + 4 * lane + 256 * j); v[j] = (f32x4){bf_lo(w.x), bf_hi(w.x), bf_lo(w.y), bf_hi(w.y)}; }
        const float rstd = rsqrtf(wave_sum(sv) * (1.f / 1024.f) + EPS);
#pragma unroll
        for (int j = 0; j < 4; ++j) *(f32x4*)(a.out + (size_t)row * 1024 + 4 * lane + 256 * j) = v[j] * rstd * gv[j];
    }
}

__global__ void __launch_bounds__(512, 2) fwd_kernel(Args a) {
    extern __shared__ __attribute__((aligned(16))) unsigned char lds_raw[];
    LAS unsigned char* lds = (LAS unsigned char*)lds_raw;
    cg::grid_group grid = cg::this_grid();
    const int lo = a.ph_lo, hi = a.ph_hi, G = gridDim.x, bid = blockIdx.x;
    unsigned char* ws = a.ws;
#define IN(k) (lo <= (k) && (k) < hi)
    if (lo < 0) grid.sync();
    if (threadIdx.x < 2) ((volatile LAS unsigned*)(lds + LDS_BYTES - 64))[threadIdx.x] = 0u;
    __syncthreads();
    const XcdBarrier bar = xcd_barrier_post((unsigned*)ws, (volatile LAS unsigned*)(lds + LDS_BYTES - 64));
#define SEAM(k) do { if (IN(k) && IN((k) + 1)) xcd_barrier(bar); } while (0)
    if (IN(0)) phase0(a, lds);
    SEAM(0);
    if (IN(1)) phase1(a);
    SEAM(1);
    if (IN(2)) {
        pg8::Gemm g{(const bf16_t*)(ws + WS_H), (const bf16_t*)(ws + WS_WIN), MT, NGEMM, 1024}; pg8::StaticOrder S; S.init(MT, NGEMM, G, bid);
        pg8::EpiProj E{(bf16_t*)(ws + WS_PROJ), (float*)(ws + WS_DT), a.in[13]};
        pg8::gemm_phase<pg8::EpiProj, pg8::StaticOrder, true, true>(lds, g, S, E);
    }
    SEAM(2);
    if (IN(3)) {
        conv_prepass(a, lds);
        acs_prepass(a);
        p3_copies(a);
        pool_items(a, lds);
    }
    SEAM(3);
    if (IN(4)) {
        for (int it = bid; it < 256; it += G) { const int pair = (it & 7) * 4 + (it >> 6), hd = (pair & 3) * 8 + ((it >> 3) & 7);
            ssd_prompt_item(a, lds, pair >> 2, hd); }
        ssd_sample_items(a, lds);
    }
    SEAM(4);
    if (IN(5)) {
        pg8::StaticOrder S; S.init(MT, 1024, G, bid);
        LAS float* lr = (LAS float*)(lds + 132096); pg8::Unit u0, u1; const bool h0 = S.next(0, u0), h1 = S.next(1, u1);
        { const int k = threadIdx.x, which = k >> 8; if (which == 0 ? h0 : h1) { const size_t row = (size_t)(which ? u1.pm : u0.pm) * 256 + (k & 255); const float* sq = (const float*)(ws + WS_SSQ) + row * 32;
              f32x4 s4 = (f32x4){0.f, 0.f, 0.f, 0.f};
#pragma unroll
              for (int q = 0; q < 8; ++q) s4 += *(const f32x4*)(sq + 4 * q);
              lr[k] = rsqrtf(((s4[0] + s4[1]) + (s4[2] + s4[3])) * (1.f / 2048.f) + EPS); } }
        { pg8::Gemm g{(const bf16_t*)(ws + WS_PM), (const bf16_t*)(ws + WS_WP), MT, 1024, 512};
          pg8::EpiPoolOut E{(const bf16_t*)(ws + WS_PROJ), (bf16_t*)(ws + WS_H)};
          pg8::gemm_phase<pg8::EpiPoolOut, pg8::StaticOrder, true, true>(lds, g, S, E); }
        __syncthreads();
        { pg8::Gemm g{(const bf16_t*)(ws + WS_YZ), (const bf16_t*)(ws + WS_WS), MT, 1024, 2048};
          pg8::EpiSsmOut E{(const bf16_t*)(ws + WS_PROJ), (bf16_t*)(ws + WS_H), lr, h0 ? u0.pm : -1};
          pg8::gemm_phase<pg8::EpiSsmOut, pg8::StaticOrder, true, true>(lds, g, S, E); }
    }
    SEAM(5);
    if (IN(6)) {
        pg8::Gemm g{(const bf16_t*)(ws + WS_H), (const bf16_t*)(ws + WS_WO), MT, 1024, 1024}; pg8::StaticOrder S; S.init(MT, 1024, G, bid);
        pg8::EpiOut E{a.in[0], a.in[1], (const float*)(ws + WS_GATE), (bf16_t*)(ws + WS_YZ), (float*)(ws + WS_SSP)};
        pg8::gemm_phase<pg8::EpiOut, pg8::StaticOrder, true, true>(lds, g, S, E);
    }
    SEAM(6);
    if (IN(7)) phase6(a);
#undef IN
#undef SEAM
}

#ifndef N_LAUNCHES
#define N_LAUNCHES 1
#endif
extern "C" void kernel_launch(void* const* d_in, const int* in_sizes, int n_in, void* d_out, int out_size, void* d_ws, size_t ws_size, hipStream_t stream) {
    static int grid = 0;
    if (grid == 0) {
        if (n_in != 23 || ws_size < WS_END) { fprintf(stderr, "kernel_launch: unexpected n_in %d / ws_size %zu\n", n_in, ws_size); grid = -1; return; }
        int dev = 0, cus = 0, per_cu = 0;
        hipGetDevice(&dev); hipDeviceGetAttribute(&cus, hipDeviceAttributeMultiprocessorCount, dev);
        if (hipFuncSetAttribute((const void*)fwd_kernel, hipFuncAttributeMaxDynamicSharedMemorySize, LDS_BYTES) != hipSuccess) { fprintf(stderr, "kernel_launch: hipFuncSetAttribute failed\n"); grid = -1; return; }
        if (hipOccupancyMaxActiveBlocksPerMultiprocessor(&per_cu, (const void*)fwd_kernel, 512, LDS_BYTES) != hipSuccess || per_cu < 1) { fprintf(stderr, "kernel_launch: occupancy query says %d\n", per_cu); per_cu = 1; }
        (void)hipGetLastError();
        grid = cus > 0 ? cus : 256;
    }
    if (grid < 0) return;
    Args a{};
    for (int i = 0; i < 23; ++i) a.in[i] = (const float*)d_in[i];
    a.out = (float*)d_out; a.ws = (unsigned char*)d_ws;
    if (hipMemsetAsync(d_ws, 0, 16384, stream) != hipSuccess) { fprintf(stderr, "kernel_launch: memset of barrier words failed\n"); return; }
    for (int li = 0; li < N_LAUNCHES; ++li) {
        a.ph_lo = (N_LAUNCHES == 1) ? 0 : li; a.ph_hi = (N_LAUNCHES == 1) ? 8 : li + 1;
        void* args[] = {&a};
        hipError_t e = hipLaunchCooperativeKernel((const void*)fwd_kernel, dim3(grid), dim3(512), args, LDS_BYTES, stream);
        if (e != hipSuccess) { fprintf(stderr, "kernel_launch: cooperative launch failed: %s (grid %d)\n", hipGetErrorString(e), grid); break; }
    }
}
```

```cpp
#include <hip/hip_runtime.h>
#include <hip/hip_cooperative_groups.h>
#include <cstdio>
#include <cstdint>
namespace cg = cooperative_groups;

#define LAS __attribute__((address_space(3)))
typedef unsigned short bf16_t;
typedef short bf16x8 __attribute__((ext_vector_type(8)));
typedef float f32x4 __attribute__((ext_vector_type(4)));
typedef unsigned u32x4 __attribute__((ext_vector_type(4)));
typedef unsigned u32x2 __attribute__((ext_vector_type(2)));

constexpr int TP = 16384, TS = 1024, MT = TP + TS;
constexpr int NPROJ = 8192;
constexpr int NGEMM = 8448;
constexpr int C_U = 0, C_ZP = 512, C_ZS = 1024, C_XBC = 3072, C_GP = 6144, C_GS = 7168;
constexpr float EPS = 1e-6f;
constexpr size_t O_YP = 0, O_YS = 16777216, O_POOLP = 17825792, O_CONVP = 17887232, O_SSMP = 17960960, O_POOLS = 20058112, O_CONVS = 21041152, O_SSMS = 22220800;
constexpr size_t MiB = 1u << 20;
constexpr size_t WS_MODP = 1 * MiB;
constexpr size_t WS_WIN = 8 * MiB;
constexpr size_t WS_H = 26 * MiB;
constexpr size_t WS_XC = 1 * MiB;
constexpr size_t WS_XBS = 18 * MiB;
constexpr size_t WS_GB = 19 * MiB;
constexpr size_t WS_XT = 35 * MiB;
constexpr size_t WS_BT = 99 * MiB;
constexpr size_t WS_XS = 115 * MiB;
constexpr size_t WS_WP = 119 * MiB;
constexpr size_t WS_WS = 120 * MiB;
constexpr size_t WS_WO = 124 * MiB;
constexpr size_t WS_WPW = 126 * MiB;
constexpr size_t WS_DT = 127 * MiB;
constexpr size_t WS_SSQ = 130 * MiB;
constexpr size_t WS_SSP = 133 * MiB;
constexpr size_t WS_GATE = 135 * MiB;
constexpr size_t WS_ACS = 136 * MiB;
constexpr size_t WS_PM = 138 * MiB;
constexpr size_t WS_YZ = 155 * MiB;
constexpr size_t WS_PROJ = 223 * MiB;
constexpr size_t WS_END = 495 * MiB;
constexpr int LDS_BYTES = 160 * 1024;

struct Args { const float* in[23]; float* out; unsigned char* ws; int ph_lo, ph_hi; };

__device__ __forceinline__ unsigned cvt_pk_bf16(float lo, float hi) { unsigned r; asm volatile("v_cvt_pk_bf16_f32 %0, %1, %2" : "=v"(r) : "v"(lo), "v"(hi)); return r; }
__device__ __forceinline__ unsigned f2bf_c(float f) { unsigned u = __builtin_bit_cast(unsigned, f); return (u + 0x7fffu + ((u >> 16) & 1u)) >> 16; }
__device__ __forceinline__ unsigned pk2_c(float lo, float hi) { return f2bf_c(lo) | (f2bf_c(hi) << 16); }
__device__ __forceinline__ float bf_lo(unsigned u) { return __builtin_bit_cast(float, u << 16); }
__device__ __forceinline__ float bf_hi(unsigned u) { return __builtin_bit_cast(float, u & 0xffff0000u); }
__device__ __forceinline__ float bf2f(bf16_t u) { return __builtin_bit_cast(float, (unsigned)u << 16); }
__device__ __forceinline__ float wave_sum(float v) {
#pragma unroll
    for (int o = 1; o < 64; o <<= 1) v += __shfl_xor(v, o);
    return v;
}
__device__ __forceinline__ float sigmoidf_(float v) { return __builtin_amdgcn_rcpf(1.f + __expf(-v)); }
__device__ __forceinline__ float siluf_(float v) { return v * sigmoidf_(v); }
__device__ __forceinline__ void unpack8(u32x4 v, float* o) { o[0] = bf_lo(v.x); o[1] = bf_hi(v.x); o[2] = bf_lo(v.y); o[3] = bf_hi(v.y); o[4] = bf_lo(v.z); o[5] = bf_hi(v.z); o[6] = bf_lo(v.w); o[7] = bf_hi(v.w); }

namespace pg8 {
constexpr int BM = 256, BK = 64, HALF = 128, HTB = HALF * BK * 2, STAGE_BYTES = 8 * HTB, NXCD = 8, WGM = 4;
__host__ __device__ __forceinline__ int lds_byte(int r, int c) { const int st = (r >> 4) * 2 + (c >> 5), rr = r & 15, cc = c & 31, ob = rr * 64 + cc * 2; return st * 1024 + (ob ^ (((ob >> 9) & 1) << 5)); }
__host__ __device__ __forceinline__ void stage_rc(int b, int& R, int& C) { const int st = b / 1024, sb = b % 1024, swz = sb ^ (((sb >> 9) & 1) << 5); R = (st >> 1) * 16 + swz / 64; C = (st & 1) * 32 + (swz % 64) / 2; }
__host__ __device__ __forceinline__ int perm32(int rho) { const int n = rho >> 4, i = rho & 15; return 8 * (i >> 2) + 4 * n + (i & 3); }
struct Unit { int pm, pn; };
struct Gemm { const bf16_t* A; const bf16_t* Bt; int M, N, K; };
struct StaticOrder {
    int nM, nN, nwg, G, c;
    __host__ __device__ void init(int M, int N, int G_, int c_) { nM = M / BM; nN = N / BM; nwg = nM * nN; G = G_; c = c_; }
    __host__ __device__ bool next(int i, Unit& u) const {
        const long L = (long)i * G + c; if (L >= nwg) return false;
        int wgid = (int)L; { const int q = nwg / NXCD, r = nwg % NXCD, xcd = wgid % NXCD, off = wgid / NXCD; wgid = (xcd < r ? xcd * (q + 1) : r * (q + 1) + (xcd - r) * q) + off; }
        const int nig = WGM * nN, gid = wgid / nig, fm = gid * WGM, gsz = (nM - fm) < WGM ? (nM - fm) : WGM;
        u.pm = fm + ((wgid % nig) % gsz); u.pn = (wgid % nig) / gsz; return true;
    }
    __device__ __forceinline__ void a_ready(const Unit&) const {}
    __device__ __forceinline__ void done(const Unit&) const {}
};

template <class Epi, class Sched, bool ALIGN_EPI = false, bool SP2 = false>
__device__ __forceinline__ void gemm_phase(LAS unsigned char* lds, const Gemm g, const Sched& S, const Epi& E) {
    const int tid = threadIdx.x, wid = __builtin_amdgcn_readfirstlane(tid >> 6), lane = tid & 63, wr = wid >> 2, wc = wid & 3, fr = lane & 15, fq = lane >> 4;
    const int K = g.K, nt = K / BK;
    unsigned voffA[2], voffB[2];
#pragma unroll
    for (int i = 0; i < 2; ++i) { int R, C; stage_rc(tid * 16 + i * 8192, R, C); const int Rb = Epi::PERM ? ((R & ~31) + perm32(R & 31)) : R;
        voffA[i] = (unsigned)(R * K + C) * 2u; voffB[i] = (unsigned)(Rb * K + C) * 2u; }
    const size_t kstep = (size_t)(BK * 2);
    const size_t hstep = (size_t)HALF * K * 2;
    const size_t tstep = 2 * hstep;
    const unsigned ldsw = (unsigned)wid * 1024u;
    const int aoff = lds_byte(wr * 64 + fr, fq * 8), boff = lds_byte(wc * 32 + fr, fq * 8);
#define PG8_SA(b, h) (((b) * 2 + (h)) * HTB)
#define PG8_SB(b, h) ((4 + (b) * 2 + (h)) * HTB)
#define PG8_STAGE(bufoff, gbase, voff) do { _Pragma("unroll") for (int _i = 0; _i < 2; ++_i) \
        __builtin_amdgcn_global_load_lds((const unsigned*)((const char*)(gbase) + (voff)[_i]), (LAS unsigned*)(lds + (bufoff) + ldsw + _i * 8192), 16, 0, 0); } while (0)
#define PG8_LDA(dst, b, h) do { _Pragma("unroll") for (int m = 0; m < 4; ++m) _Pragma("unroll") for (int k = 0; k < 2; ++k) dst[m][k] = *(const LAS bf16x8*)(lds + PG8_SA(b, h) + aoff + m * 2048 + k * 1024); } while (0)
#define PG8_LDB(dst, b, h) do { _Pragma("unroll") for (int n = 0; n < 2; ++n) _Pragma("unroll") for (int k = 0; k < 2; ++k) dst[n][k] = *(const LAS bf16x8*)(lds + PG8_SB(b, h) + boff + n * 2048 + k * 1024); } while (0)
#define PG8_MMA(ai, bj, At, Bt) do { __builtin_amdgcn_s_setprio(1); _Pragma("unroll") for (int m = 0; m < 4; ++m) _Pragma("unroll") for (int n = 0; n < 2; ++n) _Pragma("unroll") for (int k = 0; k < 2; ++k) \
        acc[ai][bj][m][n] = __builtin_amdgcn_mfma_f32_16x16x32_bf16(Bt[n][k], At[m][k], acc[ai][bj][m][n], 0, 0, 0); __builtin_amdgcn_s_setprio(0); } while (0)
#define PG8_WAIT_V(n) asm volatile("s_waitcnt vmcnt(" #n ")" ::: "memory")
#define PG8_WAIT_L(n) asm volatile("s_waitcnt lgkmcnt(" #n ")" ::: "memory")
#define PG8_BAR __builtin_amdgcn_s_barrier()
#define PG8_SCHED __builtin_amdgcn_sched_barrier(0)
    Unit cur, nxt; int ui = 0;
    if (!S.next(0, cur)) return;
    f32x4 acc[2][2][4][2];
#pragma unroll
    for (int a = 0; a < 2; ++a)
#pragma unroll
        for (int b = 0; b < 2; ++b)
#pragma unroll
            for (int m = 0; m < 4; ++m)
#pragma unroll
                for (int n = 0; n < 2; ++n) acc[a][b][m][n] = (f32x4){0.f, 0.f, 0.f, 0.f};
    bf16x8 At[4][2], B0[2][2], B1[2][2];
    const char* cA = (const char*)g.A + (size_t)cur.pm * tstep; const char* cB = (const char*)g.Bt + (size_t)cur.pn * tstep;
    S.a_ready(cur);
    if constexpr (SP2) {
        PG8_STAGE(PG8_SB(0, 0), cB, voffB); PG8_STAGE(PG8_SB(0, 1), cB + hstep, voffB); PG8_STAGE(PG8_SA(0, 0), cA, voffA); PG8_STAGE(PG8_SA(0, 1), cA + hstep, voffA);
        if (wr == 1) PG8_BAR;
        PG8_WAIT_V(2); PG8_BAR;
        PG8_STAGE(PG8_SB(1, 0), cB + kstep, voffB); PG8_STAGE(PG8_SA(1, 0), cA + kstep, voffA); PG8_STAGE(PG8_SB(1, 1), cB + hstep + kstep, voffB);
        PG8_WAIT_V(6); PG8_BAR;
    } else {
        PG8_STAGE(PG8_SB(0, 0), cB, voffB); PG8_STAGE(PG8_SA(0, 0), cA, voffA); PG8_STAGE(PG8_SB(0, 1), cB + hstep, voffB); PG8_STAGE(PG8_SA(0, 1), cA + hstep, voffA);
        if (wr == 1) PG8_BAR;
        PG8_WAIT_V(4); PG8_BAR;
        PG8_STAGE(PG8_SB(1, 0), cB + kstep, voffB); PG8_STAGE(PG8_SA(1, 0), cA + kstep, voffA); PG8_STAGE(PG8_SB(1, 1), cB + hstep + kstep, voffB);
        PG8_WAIT_V(6); PG8_BAR;
    }
    for (;;) {
        const bool has_next = S.next(ui + 1, nxt);
        const char* nA = has_next ? (const char*)g.A + (size_t)nxt.pm * tstep : cA; const char* nB = has_next ? (const char*)g.Bt + (size_t)nxt.pn * tstep : cB;
        for (int t = 0; t < nt; t += 2) {
            const bool last = (t == nt - 2);
            const char* a1 = cA + (size_t)(t + 1) * kstep;
            const char* a2 = last ? nA : cA + (size_t)(t + 2) * kstep; const char* b2 = last ? nB : cB + (size_t)(t + 2) * kstep;
            const char* a3 = a2 + kstep; const char* b3 = b2 + kstep;
            if (last && has_next) S.a_ready(nxt);
            if constexpr (SP2) {
            PG8_LDB(B0, 0, 0); PG8_LDB(B1, 0, 1); PG8_SCHED; PG8_LDA(At, 0, 0); PG8_STAGE(PG8_SA(1, 1), a1 + hstep, voffA);
            PG8_WAIT_V(8); PG8_WAIT_L(0); PG8_BAR; PG8_MMA(0, 0, At, B0); PG8_MMA(0, 1, At, B1); PG8_BAR; PG8_SCHED;
            PG8_LDA(At, 0, 1); PG8_STAGE(PG8_SB(0, 0), b2, voffB); PG8_STAGE(PG8_SB(0, 1), b2 + hstep, voffB); PG8_STAGE(PG8_SA(0, 0), a2, voffA);
            PG8_WAIT_V(8); PG8_WAIT_L(0); PG8_BAR; PG8_MMA(1, 0, At, B0); PG8_MMA(1, 1, At, B1); PG8_BAR; PG8_SCHED;
            PG8_LDB(B0, 1, 0); PG8_LDB(B1, 1, 1); PG8_SCHED; PG8_LDA(At, 1, 0); PG8_STAGE(PG8_SA(0, 1), a2 + hstep, voffA);
            PG8_WAIT_V(8); PG8_WAIT_L(0); PG8_BAR; PG8_MMA(0, 0, At, B0); PG8_MMA(0, 1, At, B1); PG8_BAR; PG8_SCHED;
            PG8_LDA(At, 1, 1); PG8_STAGE(PG8_SB(1, 0), b3, voffB); PG8_STAGE(PG8_SB(1, 1), b3 + hstep, voffB); PG8_STAGE(PG8_SA(1, 0), a3, voffA);
            PG8_WAIT_V(8); PG8_WAIT_L(0); PG8_BAR; PG8_MMA(1, 0, At, B0); PG8_MMA(1, 1, At, B1); PG8_BAR; PG8_SCHED;
            } else {
            PG8_LDB(B0, 0, 0); PG8_SCHED; PG8_LDA(At, 0, 0); PG8_STAGE(PG8_SA(1, 1), a1 + hstep, voffA);
            PG8_WAIT_L(8); PG8_BAR; PG8_WAIT_L(0); PG8_MMA(0, 0, At, B0); PG8_BAR; PG8_SCHED;
            PG8_LDB(B1, 0, 1); PG8_STAGE(PG8_SB(0, 0), b2, voffB);
            PG8_BAR; PG8_WAIT_L(0); PG8_MMA(0, 1, At, B1); PG8_BAR;
            PG8_LDA(At, 0, 1); PG8_STAGE(PG8_SA(0, 0), a2, voffA);
            PG8_BAR; PG8_WAIT_L(0); PG8_MMA(1, 0, At, B0); PG8_BAR; PG8_SCHED;
            PG8_STAGE(PG8_SB(0, 1), b2 + hstep, voffB);
            PG8_WAIT_V(6); PG8_BAR; PG8_MMA(1, 1, At, B1); PG8_BAR;
            PG8_LDB(B0, 1, 0); PG8_SCHED; PG8_LDA(At, 1, 0); PG8_STAGE(PG8_SA(0, 1), a2 + hstep, voffA);
            PG8_WAIT_L(8); PG8_BAR; PG8_WAIT_L(0); PG8_MMA(0, 0, At, B0); PG8_BAR; PG8_SCHED;
            PG8_LDB(B1, 1, 1); PG8_STAGE(PG8_SB(1, 0), b3, voffB);
            PG8_BAR; PG8_WAIT_L(0); PG8_MMA(0, 1, At, B1); PG8_BAR;
            PG8_LDA(At, 1, 1); PG8_STAGE(PG8_SA(1, 0), a3, voffA);
            PG8_BAR; PG8_WAIT_L(0); PG8_MMA(1, 0, At, B0); PG8_BAR; PG8_SCHED;
            PG8_STAGE(PG8_SB(1, 1), b3 + hstep, voffB);
            PG8_WAIT_V(6); PG8_BAR; PG8_MMA(1, 1, At, B1); PG8_BAR;
            }
        }
        if constexpr (ALIGN_EPI) { if (wr == 0) PG8_BAR; }
        if constexpr (!Epi::AFTER_DRAIN) { E(acc, cur, wr, wc, fr, fq); S.done(cur); }
        if (!has_next) break;
#pragma unroll
        for (int a = 0; a < 2; ++a)
#pragma unroll
            for (int b = 0; b < 2; ++b)
#pragma unroll
                for (int m = 0; m < 4; ++m)
#pragma unroll
                    for (int n = 0; n < 2; ++n) acc[a][b][m][n] = (f32x4){0.f, 0.f, 0.f, 0.f};
        cur = nxt; cA = nA; cB = nB; ++ui;
        if constexpr (ALIGN_EPI) { if (wr == 1) PG8_BAR; }
    }
    PG8_WAIT_V(0);
    if constexpr (!ALIGN_EPI) { if (wr == 0) PG8_BAR; }
    PG8_BAR;
#undef PG8_SA
#undef PG8_SB
#undef PG8_STAGE
#undef PG8_LDA
#undef PG8_LDB
#undef PG8_MMA
#undef PG8_WAIT_V
#undef PG8_WAIT_L
#undef PG8_BAR
#undef PG8_SCHED
}

struct EpiProj {
    static constexpr bool PERM = true, AFTER_DRAIN = false;
    bf16_t* P; float* DT; const float* dt_bias;
    __device__ __forceinline__ void operator()(const f32x4 (&acc)[2][2][4][2], const Unit& u, int wr, int wc, int fr, int fq) const {
        const int row0 = u.pm * BM + wr * 64 + fr, pn = u.pn;
        if (pn < 32) {
            const int mode = (pn < 2) ? 0 : (pn < 12) ? 1 : (pn < 24) ? 0 : 2;
            const int col0 = pn * BM + wc * 32 + 8 * fq;
#pragma unroll
            for (int ai = 0; ai < 2; ++ai)
#pragma unroll
                for (int m = 0; m < 4; ++m) { bf16_t* rowp = P + (size_t)(row0 + ai * HALF + m * 16) * NPROJ + col0;
#pragma unroll
                    for (int bj = 0; bj < 2; ++bj) { f32x4 v0 = acc[ai][bj][m][0], v1 = acc[ai][bj][m][1];
                        if (mode == 1) {
#pragma unroll
                            for (int j = 0; j < 4; ++j) { v0[j] = siluf_(v0[j]); v1[j] = siluf_(v1[j]); } }
                        else if (mode == 2) {
#pragma unroll
                            for (int j = 0; j < 4; ++j) { v0[j] = sigmoidf_(v0[j]); v1[j] = sigmoidf_(v1[j]); } }
                        u32x4 w; w.x = cvt_pk_bf16(v0[0], v0[1]); w.y = cvt_pk_bf16(v0[2], v0[3]); w.z = cvt_pk_bf16(v1[0], v1[1]); w.w = cvt_pk_bf16(v1[2], v1[3]);
                        *(u32x4*)(rowp + bj * HALF) = w; } }
        } else if (wc == 0) {
            f32x4 bv[2];
#pragma unroll
            for (int n = 0; n < 2; ++n) bv[n] = *(const f32x4*)(dt_bias + 8 * fq + 4 * n);
#pragma unroll
            for (int ai = 0; ai < 2; ++ai)
#pragma unroll
                for (int m = 0; m < 4; ++m) { float* rowp = DT + (size_t)(row0 + ai * HALF + m * 16) * 32 + 8 * fq;
#pragma unroll
                    for (int n = 0; n < 2; ++n) { f32x4 v = acc[ai][0][m][n] + bv[n];
#pragma unroll
                        for (int j = 0; j < 4; ++j) { const float e = __expf(-fabsf(v[j]));
                            const float l = e < 0.0625f ? e * (1.f - e * (0.5f - e * (0.33333334f - e * (0.25f - 0.2f * e)))) : __logf(1.f + e); v[j] = fmaxf(v[j], 0.f) + l; }
                        *(f32x4*)(rowp + 4 * n) = v; } }
        }
    }
};
struct EpiPoolOut {
    static constexpr bool PERM = true, AFTER_DRAIN = false;
    const bf16_t* P; bf16_t* MB;
    __device__ __forceinline__ void operator()(const f32x4 (&acc)[2][2][4][2], const Unit& u, int wr, int wc, int fr, int fq) const {
        const int row0 = u.pm * BM + wr * 64 + fr, col0 = u.pn * BM + wc * 32 + 8 * fq;
#pragma unroll
        for (int ai = 0; ai < 2; ++ai)
#pragma unroll
            for (int m = 0; m < 4; ++m) { const size_t row = (size_t)(row0 + ai * HALF + m * 16);
#pragma unroll
                for (int bj = 0; bj < 2; ++bj) { const int col = col0 + bj * HALF;
                    float gt[8]; unpack8(*(const u32x4*)(P + row * NPROJ + C_GP + col), gt);
                    const f32x4 v0 = acc[ai][bj][m][0], v1 = acc[ai][bj][m][1];
                    u32x4 w; w.x = cvt_pk_bf16(v0[0] * gt[0], v0[1] * gt[1]); w.y = cvt_pk_bf16(v0[2] * gt[2], v0[3] * gt[3]); w.z = cvt_pk_bf16(v1[0] * gt[4], v1[1] * gt[5]); w.w = cvt_pk_bf16(v1[2] * gt[6], v1[3] * gt[7]);
                    *(u32x4*)(MB + row * 1024 + col) = w; } }
    }
};
struct EpiSsmOut {
    static constexpr bool PERM = true, AFTER_DRAIN = false;
    const bf16_t* P; bf16_t* MB; const LAS float* lr; int pm0;
    __device__ __forceinline__ void operator()(const f32x4 (&acc)[2][2][4][2], const Unit& u, int wr, int wc, int fr, int fq) const {
        const int row0 = u.pm * BM + wr * 64 + fr, col0 = u.pn * BM + wc * 32 + 8 * fq;
        const LAS float* lru = lr + (u.pm == pm0 ? 0 : 256) + wr * 64 + fr;
#pragma unroll
        for (int ai = 0; ai < 2; ++ai)
#pragma unroll
            for (int m = 0; m < 4; ++m) { const size_t row = (size_t)(row0 + ai * HALF + m * 16);
                const float rstd = lru[ai * HALF + m * 16];
#pragma unroll
                for (int bj = 0; bj < 2; ++bj) { const int col = col0 + bj * HALF;
                    float gt[8], mv[8]; unpack8(*(const u32x4*)(P + row * NPROJ + C_GS + col), gt); unpack8(*(const u32x4*)(MB + row * 1024 + col), mv);
                    const f32x4 v0 = acc[ai][bj][m][0] * rstd, v1 = acc[ai][bj][m][1] * rstd;
                    u32x4 w; w.x = cvt_pk_bf16(mv[0] + v0[0] * gt[0], mv[1] + v0[1] * gt[1]); w.y = cvt_pk_bf16(mv[2] + v0[2] * gt[2], mv[3] + v0[3] * gt[3]);
                    w.z = cvt_pk_bf16(mv[4] + v1[0] * gt[4], mv[5] + v1[1] * gt[5]); w.w = cvt_pk_bf16(mv[6] + v1[2] * gt[6], mv[7] + v1[3] * gt[7]);
                    *(u32x4*)(MB + row * 1024 + col) = w; } }
    }
};
struct EpiOut {
    static constexpr bool PERM = false, AFTER_DRAIN = false;
    const float* xp; const float* xs; const float* gatef; bf16_t* xb; float* ssp;
    __device__ __forceinline__ void operator()(const f32x4 (&acc)[2][2][4][2], const Unit& u, int wr, int wc, int fr, int fq) const {
        const int row0 = u.pm * BM + wr * 64 + fr, col0 = u.pn * BM + wc * 32 + 4 * fq;
        const bool prompt = u.pm < 64;
        f32x4 gh[2][2];
#pragma unroll
        for (int bj = 0; bj < 2; ++bj)
#pragma unroll
            for (int n = 0; n < 2; ++n) gh[bj][n] = *(const f32x4*)(gatef + (size_t)(prompt ? (u.pm >> 3) : 8) * 1024 + col0 + bj * HALF + n * 16);
#pragma unroll
        for (int ai = 0; ai < 2; ++ai)
#pragma unroll
            for (int m = 0; m < 4; ++m) { const int row = row0 + ai * HALF + m * 16;
                const int b = row < TP ? (row >> 11) : 8 + ((row - TP) >> 3);
                const float* xr = row < TP ? xp + (size_t)row * 1024 : xs + (size_t)(row - TP) * 1024;
                const float* gr = gatef + (size_t)b * 1024;
                float ss = 0.f;
#pragma unroll
                for (int bj = 0; bj < 2; ++bj)
#pragma unroll
                    for (int n = 0; n < 2; ++n) { const int col = col0 + bj * HALF + n * 16;
                        const f32x4 gv = prompt ? gh[bj][n] : *(const f32x4*)(gr + col);
                        const f32x4 o = *(const f32x4*)(xr + col) + gv * acc[ai][bj][m][n];
                        u32x2 w; w.x = cvt_pk_bf16(o[0], o[1]); w.y = cvt_pk_bf16(o[2], o[3]); *(u32x2*)(xb + (size_t)row * 1024 + col) = w;
                        ss += (o[0] * o[0] + o[1] * o[1]) + (o[2] * o[2] + o[3] * o[3]); }
                ss += __shfl_xor(ss, 16); ss += __shfl_xor(ss, 32);
                if (fq == 0) ssp[(size_t)row * 16 + u.pn * 4 + wc] = ss; }
    }
};
}

#define XB_TMO      128
#define XB_XCNT(j)  (256  + 64 * (j))
#define XB_XSUB(j)  (1280 + 64 * (j))
#define XB_XGEN(j)  (2304 + 64 * (j))
#define XB_TOP      3328
#define XB_TOPGEN   3392
#define XCD_BAR_WORDS 3456
#define XB_SPIN_CAP (1u << 18)

__device__ __forceinline__ unsigned xb_ld(unsigned* p)              { return __hip_atomic_load(p, __ATOMIC_RELAXED, __HIP_MEMORY_SCOPE_AGENT); }
__device__ __forceinline__ unsigned xb_add(unsigned* p, unsigned v) { return __hip_atomic_fetch_add(p, v, __ATOMIC_RELAXED, __HIP_MEMORY_SCOPE_AGENT); }
__device__ __forceinline__ unsigned xb_xcc_id() { return (unsigned)__builtin_amdgcn_s_getreg((3 << 11) | 20) & 0xFu; }
#define XB_SPIN(cond, bar) do { unsigned _sp = 0; while (cond) { __builtin_amdgcn_s_sleep(1); \
    if ((++_sp & 255u) == 0u) { if (xb_ld(&(bar)[XB_TMO])) break; if (_sp > XB_SPIN_CAP) { atomicAdd(&(bar)[XB_TMO], 1u); break; } } } } while (0)

struct XcdBarrier {
    unsigned* bar; unsigned x;
    volatile LAS unsigned* st;
};

__device__ __forceinline__ XcdBarrier xcd_barrier_post(unsigned* bar, volatile LAS unsigned* st) {
    XcdBarrier b; b.bar = bar; b.x = xb_xcc_id(); b.st = st;
    if (threadIdx.x == 0) (void)xb_add(&bar[XB_XCNT(b.x)], 1u);
    return b;
}
__device__ __forceinline__ void xcd_barrier_complete(unsigned* bar, unsigned x, unsigned& nloc, unsigned& nx) {
    const unsigned G = gridDim.x * gridDim.y * gridDim.z;
    unsigned sum, cnt, mine, sp = 0u;
    for (;;) {
        sum = 0u; cnt = 0u; mine = 0u;
#pragma unroll
        for (unsigned j = 0; j < 16; ++j) { const unsigned c = xb_ld(&bar[XB_XCNT(j)]); sum += c; cnt += (c > 0u) ? 1u : 0u; mine = (j == x) ? c : mine; }
        if (sum == G) break;
        __builtin_amdgcn_s_sleep(1);
        if ((++sp & 255u) == 0u) { if (xb_ld(&bar[XB_TMO])) break; if (sp > XB_SPIN_CAP) { atomicAdd(&bar[XB_TMO], 1u); break; } }
    }
    nloc = mine > 0u ? mine : 1u; nx = cnt > 0u ? cnt : 1u;
}

__device__ __forceinline__ void xcd_barrier(const XcdBarrier& b) {
    asm volatile("s_waitcnt vmcnt(0)" ::: "memory");
    __syncthreads();
    if (threadIdx.x == 0) {
        unsigned* bar = b.bar;
        __builtin_amdgcn_s_waitcnt(0);
        unsigned nloc = b.st[0], nx = b.st[1];
        if (nloc == 0u) { xcd_barrier_complete(bar, b.x, nloc, nx); b.st[0] = nloc; b.st[1] = nx; }
        const unsigned old = xb_add(&bar[XB_XSUB(b.x)], 1u);
        const unsigned gen = old / nloc;
        if (old + 1u == (gen + 1u) * nloc) {
            __builtin_amdgcn_fence(__ATOMIC_RELEASE, "agent");
            asm volatile("s_waitcnt vmcnt(0)" ::: "memory");
            const unsigned og = xb_add(&bar[XB_TOP], 1u);
            const unsigned tg = og / nx;
            if (og + 1u == (tg + 1u) * nx) xb_add(&bar[XB_TOPGEN], 1u);
            else XB_SPIN(xb_ld(&bar[XB_TOPGEN]) == tg, bar);
            __builtin_amdgcn_fence(__ATOMIC_ACQUIRE, "agent");
            xb_add(&bar[XB_XGEN(b.x)], 1u);
            asm volatile("s_waitcnt vmcnt(0)" ::: "memory");
        } else {
            XB_SPIN(xb_ld(&bar[XB_XGEN(b.x)]) == gen, bar);
            __builtin_amdgcn_fence(__ATOMIC_ACQUIRE, "agent");
            asm volatile("s_waitcnt vmcnt(0)" ::: "memory");
        }
    }
    __syncthreads();
}

constexpr int LSTR = 272;
constexpr int L_C = 0, L_B = 34816, L_BWT = 69632, L_XT = 104448, L_H = 121856, L_SC = 139264;
#define MFMA16(a, b, c) __builtin_amdgcn_mfma_f32_16x16x32_bf16(a, b, c, 0, 0, 0)

__device__ __forceinline__ void p0_transpose_item(const float* W, int K, int N, bf16_t* WT, int kb, int nb, int out_row0, LAS float* scr, int lane, const float* kscale) {
    const int k0 = 64 * kb, n0 = 32 * nb;
    float tv[32];
#pragma unroll
    for (int i = 0; i < 32; ++i) tv[i] = W[(size_t)(k0 + 2 * i + (lane >> 5)) * N + n0 + (lane & 31)];
#pragma unroll
    for (int i = 0; i < 32; ++i) { const int kk = 2 * i + (lane >> 5); float v = tv[i]; if (kscale) v *= kscale[k0 + kk]; scr[kk * 33 + (lane & 31)] = v; }
    asm volatile("s_waitcnt lgkmcnt(0)" ::: "memory");
    const int c = lane & 7;
#pragma unroll
    for (int j = 0; j < 4; ++j) { const int n = (lane >> 3) + 8 * j; const LAS float* s = scr + (8 * c) * 33 + n;
        u32x4 o; o.x = cvt_pk_bf16(s[0 * 33], s[1 * 33]); o.y = cvt_pk_bf16(s[2 * 33], s[3 * 33]); o.z = cvt_pk_bf16(s[4 * 33], s[5 * 33]); o.w = cvt_pk_bf16(s[6 * 33], s[7 * 33]);
        *(u32x4*)(WT + (size_t)(out_row0 + n) * K + k0 + 8 * c) = o; }
    asm volatile("s_waitcnt lgkmcnt(0)" ::: "memory");
}
__device__ __forceinline__ void phase0(const Args& a, LAS unsigned char* lds) {
    const int tid = threadIdx.x, lane = tid & 63, wave = tid >> 6, G = gridDim.x, bid = blockIdx.x;
    unsigned char* ws = a.ws;
    for (int item = bid; item < 192; item += G) {
        const int ks = item & 3, cs = (item >> 2) % 6, rg = item / 24;
        LAS float* sc = (LAS float*)lds;
        __syncthreads();
        for (int e = tid; e < 17 * 256; e += 512) { const int r = e >> 8, k = e & 255, row = rg * 17 + r;
            const float* cp = row < 8 ? a.in[5] + row * 1024 : a.in[6] + (row - 8) * 1024;
            const float v = cp[ks * 256 + k]; sc[e] = v / (1.f + __expf(-v)); }
        __syncthreads();
        const int col = cs * 512 + wave * 64 + lane;
        const float* wp = a.in[7] + (size_t)(ks * 256) * 3072 + col;
        float acc[17];
#pragma unroll
        for (int r = 0; r < 17; ++r) acc[r] = 0.f;
#pragma unroll 1
        for (int k16 = 0; k16 < 16; ++k16) {
            float w[16];
#pragma unroll
            for (int q = 0; q < 16; ++q) w[q] = wp[(size_t)(16 * k16 + q) * 3072];
#pragma unroll
            for (int q4 = 0; q4 < 4; ++q4) {
#pragma unroll
                for (int r = 0; r < 17; ++r) { const f32x4 s = *(const LAS f32x4*)(sc + r * 256 + 16 * k16 + 4 * q4); acc[r] += (s[0] * w[4 * q4] + s[1] * w[4 * q4 + 1]) + (s[2] * w[4 * q4 + 2] + s[3] * w[4 * q4 + 3]); } }
        }
        float* mp = (float*)(ws + WS_MODP) + ((size_t)ks * 136 + rg * 17) * 3072 + col;
#pragma unroll
        for (int r = 0; r < 17; ++r) mp[(size_t)r * 3072] = acc[r];
    }
    __syncthreads();
    { u32x4* z = (u32x4*)(ws + WS_WIN + (size_t)8224 * 1024 * 2); const u32x4 zero = (u32x4){0u, 0u, 0u, 0u};
      for (int e = bid * 512 + tid; e < 224 * 1024 * 2 / 16; e += G * 512) z[e] = zero; }
    LAS float* scr = (LAS float*)(lds + wave * 16384);
    const int tb0 = G > 224 ? 192 : 0;
    if (bid < tb0) return;
    const int gw = (bid - tb0) * 8 + wave, NGW = (G - tb0) * 8;
    constexpr int I_IN = 16 * 257, I_P = 8 * 32, I_S = 32 * 32, I_O = 16 * 32, I_PW = 4 * 8;
    for (int it = gw; it < I_IN + I_P + I_S + I_O + I_PW; it += NGW) {
        int r = it;
        if (r < I_IN) { const int kb = r / 257, nb = r % 257; const int orow = nb < 192 ? 32 * nb : (nb == 192 ? 8192 : 32 * nb - 32);
            p0_transpose_item(a.in[10], 1024, 8224, (bf16_t*)(ws + WS_WIN), kb, nb, orow, scr, lane, nullptr); continue; } r -= I_IN;
        if (r < I_P) { p0_transpose_item(a.in[19], 512, 1024, (bf16_t*)(ws + WS_WP), r / 32, r % 32, 32 * (r % 32), scr, lane, nullptr); continue; } r -= I_P;
        if (r < I_S) { p0_transpose_item(a.in[20], 2048, 1024, (bf16_t*)(ws + WS_WS), r / 32, r % 32, 32 * (r % 32), scr, lane, a.in[16]); continue; } r -= I_S;
        if (r < I_O) { p0_transpose_item(a.in[21], 1024, 1024, (bf16_t*)(ws + WS_WO), r / 32, r % 32, 32 * (r % 32), scr, lane, nullptr); continue; } r -= I_O;
        { const int g = r >> 3, q = r & 7; p0_transpose_item(a.in[17] + (size_t)g * 16384, 128, 128, (bf16_t*)(ws + WS_WPW) + (size_t)g * 16384, q >> 2, q & 3, 32 * (q & 3), scr, lane, nullptr); }
    }
}

__device__ __forceinline__ void phase1(const Args& a) {
    const int tid = threadIdx.x, lane = tid & 63, wave = tid >> 6, G = gridDim.x, bid = blockIdx.x;
    const int gw = bid * 8 + wave, NGW = G * 8;
    const float* modp = (const float*)(a.ws + WS_MODP); const float* b_ada = a.in[8]; const float* ng = a.in[9];
    bf16_t* H = (bf16_t*)(a.ws + WS_H);
    for (int grp = gw; grp < TP / 8; grp += NGW) {
        const int row0 = grp * 8; const int b = row0 < TP ? (row0 >> 11) : 8 + ((row0 - TP) >> 3);
        f32x4 gs[4], sh[4];
#pragma unroll
        for (int j = 0; j < 4; ++j) { const int k = 4 * lane + 256 * j;
            f32x4 shift = *(const f32x4*)(b_ada + k), scale = *(const f32x4*)(b_ada + 1024 + k);
#pragma unroll
            for (int ks = 0; ks < 4; ++ks) { const float* mp = modp + ((size_t)ks * 136 + b) * 3072 + k; shift += *(const f32x4*)mp; scale += *(const f32x4*)(mp + 1024); }
            gs[j] = *(const f32x4*)(ng + k) * (scale + 1.f); sh[j] = shift; }
#pragma unroll 1
        for (int r4 = 0; r4 < 8; r4 += 4) {
            f32x4 v[4][4];
#pragma unroll
            for (int u = 0; u < 4; ++u) { const int row = row0 + r4 + u; const float* xr = row < TP ? a.in[0] + (size_t)row * 1024 : a.in[1] + (size_t)(row - TP) * 1024;
#pragma unroll
                for (int j = 0; j < 4; ++j) v[u][j] = *(const f32x4*)(xr + 4 * lane + 256 * j); }
#pragma unroll
            for (int u = 0; u < 4; ++u) { const int row = row0 + r4 + u; float s = 0.f;
#pragma unroll
                for (int j = 0; j < 4; ++j) s += (v[u][j][0] * v[u][j][0] + v[u][j][1] * v[u][j][1]) + (v[u][j][2] * v[u][j][2] + v[u][j][3] * v[u][j][3]);
                const float rstd = rsqrtf(wave_sum(s) * (1.f / 1024.f) + EPS);
#pragma unroll
                for (int j = 0; j < 4; ++j) { const f32x4 o = v[u][j] * rstd * gs[j] + sh[j]; u32x2 w; w.x = cvt_pk_bf16(o[0], o[1]); w.y = cvt_pk_bf16(o[2], o[3]);
                    *(u32x2*)(H + (size_t)row * 1024 + 4 * lane + 256 * j) = w; } } }
    }
    for (int row = TP + gw; row < MT; row += NGW) {
        const int b = 8 + ((row - TP) >> 3); const float* xr = a.in[1] + (size_t)(row - TP) * 1024;
        f32x4 v[4]; float s = 0.f;
#pragma unroll
        for (int j = 0; j < 4; ++j) { v[j] = *(const f32x4*)(xr + 4 * lane + 256 * j); s += (v[j][0] * v[j][0] + v[j][1] * v[j][1]) + (v[j][2] * v[j][2] + v[j][3] * v[j][3]); }
        const float rstd = rsqrtf(wave_sum(s) * (1.f / 1024.f) + EPS);
#pragma unroll
        for (int j = 0; j < 4; ++j) { const int k = 4 * lane + 256 * j;
            f32x4 shift = *(const f32x4*)(b_ada + k), scale = *(const f32x4*)(b_ada + 1024 + k);
#pragma unroll
            for (int ks = 0; ks < 4; ++ks) { const float* mp = modp + ((size_t)ks * 136 + b) * 3072 + k; shift += *(const f32x4*)mp; scale += *(const f32x4*)(mp + 1024); }
            const f32x4 o = v[j] * rstd * (*(const f32x4*)(ng + k) * (scale + 1.f)) + shift; u32x2 w; w.x = cvt_pk_bf16(o[0], o[1]); w.y = cvt_pk_bf16(o[2], o[3]);
            *(u32x2*)(H + (size_t)row * 1024 + k) = w; }
    }
    float* gatef = (float*)(a.ws + WS_GATE);
    for (int e = bid * 512 + tid; e < 136 * 256; e += G * 512) { const int b = e >> 8, k = (e & 255) * 4;
        f32x4 gt = *(const f32x4*)(b_ada + 2048 + k);
#pragma unroll
        for (int ks = 0; ks < 4; ++ks) gt += *(const f32x4*)(modp + ((size_t)ks * 136 + b) * 3072 + 2048 + k);
        *(f32x4*)(gatef + (size_t)b * 1024 + k) = gt; }
}


__device__ __forceinline__ void p3_copies(const Args& a) {
    const int G = gridDim.x; const bf16_t* P = (const bf16_t*)(a.ws + WS_PROJ); float* out = a.out;
    const float* spool = a.in[2];
    const bool slack = (G == 256); if (slack && (blockIdx.x < 96 || blockIdx.x >= 224)) return;
    const int vb = slack ? (int)blockIdx.x - 96 : (int)blockIdx.x, NB = slack ? 128 : G;
    for (int w = vb * 512 + threadIdx.x; w < 2297856 / 8; w += NB * 512) {
        const int e = w * 8; const bf16_t* src = nullptr; const float* fsrc = nullptr; float* dst;
        if (e < 61440) { const int b = e / 7680, r = (e / 512) % 15, c = e & 511; src = P + (size_t)(b * 2048 + 2033 + r) * NPROJ + C_U + c; dst = out + O_POOLP + e; }
        else if (e < 61440 + 73728) { const int f = e - 61440, b = f / 9216, r = (f / 3072) % 3, c = f % 3072; src = P + (size_t)(b * 2048 + 2045 + r) * NPROJ + C_XBC + c; dst = out + O_CONVP + f; }
        else if (e < 61440 + 73728 + 983040) { const int f = e - 135168, b = f / 7680, r = (f / 512) % 15, c = f & 511; dst = out + O_POOLS + f;
            if (r < 7) fsrc = spool + (size_t)(b * 15 + 8 + r) * 512 + c; else src = P + (size_t)(TP + b * 8 + r - 7) * NPROJ + C_U + c; }
        else { const int f = e - 1118208, b = f / 9216, r = (f / 3072) % 3, c = f % 3072; src = P + (size_t)(TP + b * 8 + 5 + r) * NPROJ + C_XBC + c; dst = out + O_CONVS + f; }
        f32x4 o0, o1;
        if (fsrc) { o0 = *(const f32x4*)fsrc; o1 = *(const f32x4*)(fsrc + 4); }
        else { float u[8]; unpack8(*(const u32x4*)src, u); o0 = (f32x4){u[0], u[1], u[2], u[3]}; o1 = (f32x4){u[4], u[5], u[6], u[7]}; }
        *(f32x4*)dst = o0; *(f32x4*)(dst + 4) = o1;
    }
}

__device__ __forceinline__ void conv_prepass(const Args& a, LAS unsigned char* lds) {
    const int G = gridDim.x; const bf16_t* P = (const bf16_t*)(a.ws + WS_PROJ);
    bf16_t* XC = (bf16_t*)(a.ws + WS_XC); bf16_t* XBS = (bf16_t*)(a.ws + WS_XBS); bf16_t* XT = (bf16_t*)(a.ws + WS_XT); bf16_t* BT = (bf16_t*)(a.ws + WS_BT); bf16_t* XS = (bf16_t*)(a.ws + WS_XS);
    const float* convw = a.in[11]; const float* convb = a.in[12]; const float* sconv = a.in[3];
    for (int tile = blockIdx.x; tile < 136 * 12; tile += G) {
        const int ci = tile / 12, og = tile % 12; const bool samp = ci >= 128;
        const int l32 = threadIdx.x & 31, rl = threadIdx.x >> 5, gq = og - 8;
        const int oc = og < 8 ? og * 32 + l32 : (l32 < 16 ? 256 + gq * 16 + l32 : 320 + gq * 16 + (l32 - 16)), run = (samp ? ci - 128 : ci) * 16 + rl, xcol = oc * 8;
        float cw[4][8], cb[8];
#pragma unroll
        for (int k = 0; k < 4; ++k) { const f32x4 w0 = *(const f32x4*)(convw + k * 3072 + xcol), w1 = *(const f32x4*)(convw + k * 3072 + xcol + 4);
#pragma unroll
            for (int e = 0; e < 4; ++e) { cw[k][e] = w0[e]; cw[k][4 + e] = w1[e]; } }
        { const f32x4 b0 = *(const f32x4*)(convb + xcol), b1 = *(const f32x4*)(convb + xcol + 4);
#pragma unroll
          for (int e = 0; e < 4; ++e) { cb[e] = b0[e]; cb[4 + e] = b1[e]; } }
        const int R0 = samp ? TP + run * 8 : run * 8, pos0 = R0 & 2047;
        u32x4 rawp[11];
#pragma unroll
        for (int d = 0; d < 11; ++d) rawp[d] = (d >= 3 || (!samp && pos0 > 0)) ? *(const u32x4*)(P + (size_t)(R0 - 3 + d) * NPROJ + C_XBC + xcol) : (u32x4){0u, 0u, 0u, 0u};
        float hist[3][8];
#pragma unroll
        for (int d = 0; d < 3; ++d) {
            if (samp) { const float* sp = sconv + (size_t)(run * 3 + d) * 3072 + xcol; const f32x4 h0 = *(const f32x4*)sp, h1 = *(const f32x4*)(sp + 4);
#pragma unroll
                for (int e = 0; e < 4; ++e) { hist[d][e] = h0[e]; hist[d][4 + e] = h1[e]; } }
            else unpack8(rawp[d], hist[d]); }
        u32x4 nat[8]; float tv[8][8];
#pragma unroll
        for (int t = 0; t < 8; ++t) { float v[8];
#pragma unroll
            for (int e = 0; e < 8; ++e) v[e] = cb[e];
#pragma unroll
            for (int k = 0; k < 4; ++k) { float rw[8];
                if (t + k < 3) {
#pragma unroll
                    for (int e = 0; e < 8; ++e) rw[e] = hist[t + k][e]; }
                else unpack8(rawp[t + k], rw);
#pragma unroll
                for (int e = 0; e < 8; ++e) v[e] += cw[k][e] * rw[e]; }
#pragma unroll
            for (int e = 0; e < 8; ++e) { v[e] = siluf_(v[e]); tv[e][t] = v[e]; }
            nat[t].x = cvt_pk_bf16(v[0], v[1]); nat[t].y = cvt_pk_bf16(v[2], v[3]); nat[t].z = cvt_pk_bf16(v[4], v[5]); nat[t].w = cvt_pk_bf16(v[6], v[7]); }
        if (oc >= 256) {
            if (oc >= 320) {
#pragma unroll
                for (int t = 0; t < 8; ++t) *(u32x4*)(XC + (size_t)(R0 + t) * 512 + (oc - 320) * 8) = nat[t]; }
            else if (samp) {
#pragma unroll
                for (int t = 0; t < 8; ++t) *(u32x4*)(XBS + (size_t)(run * 8 + t) * 512 + (oc - 256) * 8) = nat[t]; }
            if (!samp) { const int base = l32 < 16 ? L_B + l32 * 16 : L_C + (l32 - 16) * 16;
#pragma unroll
                for (int t = 0; t < 8; ++t) *(LAS u32x4*)(lds + base + (rl * 8 + t) * LSTR) = nat[t]; } }
        else if (samp) {
#pragma unroll
            for (int t = 0; t < 8; ++t) *(u32x4*)(XS + (size_t)(run * 8 + t) * 2048 + xcol) = nat[t]; }
        if (!samp && oc < 320) {
            const int bc = R0 >> 7, j0 = R0 & 127;
            bf16_t* dst = oc < 256 ? XT + ((size_t)(bc * 32 + (oc >> 3)) * 64 + (oc & 7) * 8) * 128 + j0 : BT + ((size_t)(bc * 4 + ((oc - 256) >> 4)) * 128 + ((oc - 256) & 15) * 8) * 128 + j0;
#pragma unroll
            for (int e = 0; e < 8; ++e) { u32x4 w; w.x = cvt_pk_bf16(tv[e][0], tv[e][1]); w.y = cvt_pk_bf16(tv[e][2], tv[e][3]); w.z = cvt_pk_bf16(tv[e][4], tv[e][5]); w.w = cvt_pk_bf16(tv[e][6], tv[e][7]);
                *(u32x4*)(dst + (size_t)e * 128) = w; } }
        if (og >= 8 && !samp) {
            __syncthreads();
            const int lane = threadIdx.x & 63, wave = threadIdx.x >> 6, fr = lane & 15, fq = lane >> 4, wi = wave >> 1, wj = wave & 1, i0 = 32 * wi, jb0 = 64 * wj;
            f32x4 gacc[2][4];
#pragma unroll
            for (int mi = 0; mi < 2; ++mi)
#pragma unroll
                for (int nj = 0; nj < 4; ++nj) gacc[mi][nj] = (f32x4){0.f, 0.f, 0.f, 0.f};
#pragma unroll
            for (int ks = 0; ks < 4; ++ks) { bf16x8 af[2], bfr[4];
#pragma unroll
                for (int mi = 0; mi < 2; ++mi) af[mi] = *(const LAS bf16x8*)(lds + L_C + (i0 + 16 * mi + fr) * LSTR + ks * 64 + fq * 16);
#pragma unroll
                for (int nj = 0; nj < 4; ++nj) bfr[nj] = *(const LAS bf16x8*)(lds + L_B + (jb0 + 16 * nj + fr) * LSTR + ks * 64 + fq * 16);
#pragma unroll
                for (int mi = 0; mi < 2; ++mi)
#pragma unroll
                    for (int nj = 0; nj < 4; ++nj) gacc[mi][nj] = MFMA16(bfr[nj], af[mi], gacc[mi][nj]); }
            bf16_t* gb = (bf16_t*)(a.ws + WS_GB) + (size_t)(ci * 4 + gq) * 16384;
#pragma unroll
            for (int mi = 0; mi < 2; ++mi)
#pragma unroll
                for (int nj = 0; nj < 4; ++nj) { u32x2 w; w.x = pk2_c(gacc[mi][nj][0], gacc[mi][nj][1]); w.y = pk2_c(gacc[mi][nj][2], gacc[mi][nj][3]);
                    *(u32x2*)(gb + (size_t)(i0 + 16 * mi + fr) * 128 + jb0 + 16 * nj + 4 * fq) = w; }
            __syncthreads();
        }
    }
}
__device__ __forceinline__ void acs_prepass(const Args& a) {
    const int lane = threadIdx.x & 63, wave = threadIdx.x >> 6, G = gridDim.x;
    const bool slack = (G == 256);
    if (slack ? (wave >= 4 || blockIdx.x < 96 || blockIdx.x >= 224) : (wave >= 2)) return;
    const float* DT = (const float*)(a.ws + WS_DT); float* ACS = (float*)(a.ws + WS_ACS);
    const int h8 = lane & 7, seg = lane >> 3;
    for (int wi = slack ? ((int)blockIdx.x - 96) * 4 + wave : (int)blockIdx.x * 2 + wave; wi < 512; wi += slack ? 512 : G * 2) {
        const int ck = wi >> 2, head = (wi & 3) * 8 + h8; const float Aneg = -__expf(a.in[14][head]);
        const float* dp = DT + (size_t)(ck * 128 + 16 * seg) * 32 + head; float* ap = ACS + (size_t)(ck * 128 + 16 * seg) * 32 + head;
        float v[16]; float tot = 0.f;
#pragma unroll
        for (int t = 0; t < 16; ++t) v[t] = dp[t * 32];
#pragma unroll
        for (int t = 0; t < 16; ++t) { v[t] *= Aneg; tot += v[t]; }
        float pre = 0.f;
#pragma unroll
        for (int sgm = 0; sgm < 7; ++sgm) { const float ts = __shfl(tot, h8 + 8 * sgm); if (sgm < seg) pre += ts; }
        float run = pre;
#pragma unroll
        for (int t = 0; t < 16; ++t) { run += v[t]; ap[t * 32] = run; }
    }
}

__device__ __forceinline__ void ssd_prompt_item(const Args& a, LAS unsigned char* lds, int b, int head) {
    const int tid = threadIdx.x, lane = tid & 63, wave = tid >> 6, fr = lane & 15, fq = lane >> 4, g = head >> 3;
    const bf16_t* P = (const bf16_t*)(a.ws + WS_PROJ); const bf16_t* XC = (const bf16_t*)(a.ws + WS_XC); const bf16_t* XT = (const bf16_t*)(a.ws + WS_XT); const bf16_t* BT = (const bf16_t*)(a.ws + WS_BT); const bf16_t* GB = (const bf16_t*)(a.ws + WS_GB);
    const float* DT = (const float*)(a.ws + WS_DT); const float* ACS = (const float*)(a.ws + WS_ACS);
    bf16_t* YZ = (bf16_t*)(a.ws + WS_YZ); float* SSQ = (float*)(a.ws + WS_SSQ);
    const float Dsk = a.in[15][head];
    LAS float* sS = (LAS float*)(lds + L_SC);
    u32x4 pf[14]; u32x2 zf[4]; float pa = 0.f, pd = 0.f;
#define SSD_ISSUE(c_) do { const int R0n = b * 2048 + (c_) * 128, bcn = b * 16 + (c_); \
        if (tid < 128) { pa = ACS[(size_t)(R0n + tid) * 32 + head]; pd = DT[(size_t)(R0n + tid) * 32 + head]; } \
        _Pragma("unroll") for (int i = 0; i < 4; ++i) { const int q = tid + 512 * i; pf[i] = *(const u32x4*)(XC + (size_t)(R0n + (q >> 4)) * 512 + g * 128 + (q & 15) * 8); } \
        _Pragma("unroll") for (int i = 0; i < 4; ++i) { const int q = tid + 512 * i; pf[4 + i] = ((q & 15) * 8 <= (q >> 4)) ? *(const u32x4*)(GB + ((size_t)(bcn * 4 + g) * 128 + (q >> 4)) * 128 + (q & 15) * 8) : (u32x4){0u, 0u, 0u, 0u}; } \
        _Pragma("unroll") for (int i = 0; i < 4; ++i) { const int q = tid + 512 * i; pf[8 + i] = *(const u32x4*)(BT + ((size_t)(bcn * 4 + g) * 128 + (q >> 4)) * 128 + (q & 15) * 8); } \
        _Pragma("unroll") for (int i = 0; i < 2; ++i) { const int q = tid + 512 * i; pf[12 + i] = *(const u32x4*)(XT + ((size_t)(bcn * 32 + head) * 64 + (q >> 4)) * 128 + (q & 15) * 8); } } while (0)
#define SSD_ISSUE_Z(c_) do { const int R0n = b * 2048 + (c_) * 128; \
        _Pragma("unroll") for (int k = 0; k < 4; ++k) zf[k] = *(const u32x2*)(P + (size_t)(R0n + 16 * wave + fr) * NPROJ + C_ZS + head * 64 + 16 * k + 4 * fq); } while (0)
    __syncthreads();
    SSD_ISSUE(0); SSD_ISSUE_Z(0);
    for (int e = tid; e < 64 * LSTR / 16; e += 512) *(LAS u32x4*)(lds + L_H + e * 16) = (u32x4){0u, 0u, 0u, 0u};
    if (tid < 128) { sS[tid] = pa; sS[128 + tid] = pd; }
    __syncthreads();
    f32x4 hacc[4];
#pragma unroll
    for (int k = 0; k < 4; ++k) hacc[k] = (f32x4){0.f, 0.f, 0.f, 0.f};
#pragma unroll 1
    for (int c = 0; c < 16; ++c) {
        const int R0 = b * 2048 + c * 128;
        LAS float* sAcs = sS + (c & 1) * 256; LAS float* sDt = sAcs + 128;
        const float last = sAcs[127];
        { const int jo = tid & 15; float w8[8], aj[8], dj[8];
          { const f32x4 a0 = *(const LAS f32x4*)(sAcs + jo * 8), a1 = *(const LAS f32x4*)(sAcs + jo * 8 + 4), d0 = *(const LAS f32x4*)(sDt + jo * 8), d1 = *(const LAS f32x4*)(sDt + jo * 8 + 4);
#pragma unroll
            for (int e = 0; e < 4; ++e) { aj[e] = a0[e]; aj[4 + e] = a1[e]; dj[e] = d0[e]; dj[4 + e] = d1[e]; }
#pragma unroll
            for (int e = 0; e < 8; ++e) w8[e] = __expf(last - aj[e]) * dj[e]; }
#pragma unroll
          for (int i = 0; i < 4; ++i) { const int q = tid + 512 * i, ii = q >> 4, off = ii * LSTR + jo * 16;
              *(LAS u32x4*)(lds + L_C + off) = pf[i];
              { float gv[8]; unpack8(pf[4 + i], gv); const float ai = sAcs[ii]; float at[8];
#pragma unroll
                for (int e = 0; e < 8; ++e) { const float v = gv[e] * __expf(fminf(ai - aj[e], 0.f)) * dj[e]; at[e] = (jo * 8 + e <= ii) ? v : 0.f; }
                u32x4 w; w.x = cvt_pk_bf16(at[0], at[1]); w.y = cvt_pk_bf16(at[2], at[3]); w.z = cvt_pk_bf16(at[4], at[5]); w.w = cvt_pk_bf16(at[6], at[7]);
                *(LAS u32x4*)(lds + L_B + off) = w; }
              float bv[8]; unpack8(pf[8 + i], bv); u32x4 w; w.x = cvt_pk_bf16(bv[0] * w8[0], bv[1] * w8[1]); w.y = cvt_pk_bf16(bv[2] * w8[2], bv[3] * w8[3]); w.z = cvt_pk_bf16(bv[4] * w8[4], bv[5] * w8[5]); w.w = cvt_pk_bf16(bv[6] * w8[6], bv[7] * w8[7]);
              *(LAS u32x4*)(lds + L_BWT + off) = w; }
#pragma unroll
          for (int i = 0; i < 2; ++i) { const int q = tid + 512 * i; *(LAS u32x4*)(lds + L_XT + (q >> 4) * LSTR + jo * 16) = pf[12 + i]; } }
        if (c + 1 < 16) SSD_ISSUE(c + 1);
        __syncthreads();
        const int irow = 16 * wave + fr;
        f32x4 yacc[4];
#pragma unroll
        for (int k = 0; k < 4; ++k) yacc[k] = (f32x4){0.f, 0.f, 0.f, 0.f};
#pragma unroll
        for (int ks = 0; ks < 4; ++ks) { const bf16x8 cf = *(const LAS bf16x8*)(lds + L_C + irow * LSTR + ks * 64 + fq * 16);
#pragma unroll
            for (int k = 0; k < 4; ++k) { const bf16x8 hf = *(const LAS bf16x8*)(lds + L_H + (16 * k + fr) * LSTR + ks * 64 + fq * 16); yacc[k] = MFMA16(hf, cf, yacc[k]); } }
        { const float ea = __expf(sAcs[irow]), dec = __expf(last);
#pragma unroll
          for (int k = 0; k < 4; ++k) { yacc[k] *= ea; hacc[k] *= dec; } }
#pragma unroll
        for (int ks = 0; ks < 4; ++ks) { const bf16x8 af = *(const LAS bf16x8*)(lds + L_B + irow * LSTR + ks * 64 + fq * 16);
            const bf16x8 bwf = *(const LAS bf16x8*)(lds + L_BWT + irow * LSTR + ks * 64 + fq * 16);
#pragma unroll
            for (int k = 0; k < 4; ++k) { const bf16x8 xf = *(const LAS bf16x8*)(lds + L_XT + (16 * k + fr) * LSTR + ks * 64 + fq * 16);
                yacc[k] = MFMA16(xf, af, yacc[k]); hacc[k] = MFMA16(xf, bwf, hacc[k]); } }
        { const size_t row = (size_t)(R0 + irow); float ssq = 0.f;
#pragma unroll
          for (int k = 0; k < 4; ++k) { const int p0 = 16 * k + 4 * fq; const u32x2 zz = zf[k];
              float yz[4];
#pragma unroll
              for (int r = 0; r < 4; ++r) { const float xv = bf2f(*(const LAS unsigned short*)(lds + L_XT + (p0 + r) * LSTR + irow * 2));
                  const float z = r == 0 ? bf_lo(zz.x) : r == 1 ? bf_hi(zz.x) : r == 2 ? bf_lo(zz.y) : bf_hi(zz.y);
                  yz[r] = (yacc[k][r] + Dsk * xv) * z; ssq += yz[r] * yz[r]; }
              u32x2 w; w.x = cvt_pk_bf16(yz[0], yz[1]); w.y = cvt_pk_bf16(yz[2], yz[3]);
              *(u32x2*)(YZ + row * 2048 + head * 64 + p0) = w; }
          ssq += __shfl_xor(ssq, 16); ssq += __shfl_xor(ssq, 32);
          if (fq == 0) SSQ[row * 32 + head] = ssq; }
        if (c + 1 < 16) SSD_ISSUE_Z(c + 1);
        if (tid < 128 && c + 1 < 16) { LAS float* nS = sS + ((c + 1) & 1) * 256; nS[tid] = pa; nS[128 + tid] = pd; }
        __syncthreads();
#pragma unroll
        for (int k = 0; k < 4; ++k)
#pragma unroll
            for (int r = 0; r < 4; ++r) *(LAS unsigned short*)(lds + L_H + (16 * k + 4 * fq + r) * LSTR + (16 * wave + fr) * 2) = (unsigned short)(cvt_pk_bf16(hacc[k][r], 0.f) & 0xffffu);
    }
#undef SSD_ISSUE
#undef SSD_ISSUE_Z
    float* so = a.out + O_SSMP + (size_t)(b * 32 + head) * 8192;
#pragma unroll
    for (int k = 0; k < 4; ++k)
#pragma unroll
        for (int r = 0; r < 4; ++r) so[(16 * k + 4 * fq + r) * 128 + 16 * wave + fr] = hacc[k][r];
}

#define WAVE_LDS_SYNC() asm volatile("s_waitcnt lgkmcnt(0)" ::: "memory")
__device__ __forceinline__ void ssd_sample_items(const Args& a, LAS unsigned char* lds) {
    const int tid = threadIdx.x, lane = tid & 63, wave = tid >> 6, fr = lane & 15, fq = lane >> 4, G = gridDim.x;
    const bf16_t* P = (const bf16_t*)(a.ws + WS_PROJ); const bf16_t* XC = (const bf16_t*)(a.ws + WS_XC); const bf16_t* XBS = (const bf16_t*)(a.ws + WS_XBS); const bf16_t* XS = (const bf16_t*)(a.ws + WS_XS); const float* DT = (const float*)(a.ws + WS_DT);
    bf16_t* YZ = (bf16_t*)(a.ws + WS_YZ); float* SSQ = (float*)(a.ws + WS_SSQ); const float* sssm = a.in[4];
    LAS float* sxw = (LAS float*)(lds + wave * 9216); LAS float* sbw = sxw + 512; LAS float* satt = sbw + 1024; LAS float* sy = satt + 64;
    const int jx = lane >> 3, ox = lane & 7, tf = fr & 7;
    __syncthreads();
#pragma unroll 1
    for (int item = blockIdx.x * 8 + wave; item < 4096; item += G * 8) {
        const int bb = item >> 5, head = item & 31, g = head >> 3, R0 = TP + bb * 8;
        const float* hp = sssm + (size_t)item * 8192; float* so = a.out + O_SSMS + (size_t)item * 8192;
        f32x4 h[2][4][2];
#define SMP_LOAD_H(hh) do { _Pragma("unroll") for (int q = 0; q < 2; ++q) _Pragma("unroll") for (int ks = 0; ks < 4; ++ks) { \
            const float* p_ = hp + (16 * (2 * (hh) + q) + fr) * 128 + 32 * ks + 8 * fq; h[q][ks][0] = *(const f32x4*)p_; h[q][ks][1] = *(const f32x4*)(p_ + 4); } } while (0)
        SMP_LOAD_H(0);
        const float dtl = lane < 8 ? DT[(size_t)(R0 + lane) * 32 + head] : 0.f;
        const u32x4 xr = *(const u32x4*)(XS + (size_t)(bb * 8 + jx) * 2048 + head * 64 + ox * 8);
        const u32x4 zr = *(const u32x4*)(P + (size_t)(R0 + jx) * NPROJ + C_ZS + head * 64 + ox * 8);
        u32x4 br[2];
#pragma unroll
        for (int k = 0; k < 2; ++k) { const int piece = lane + 64 * k; br[k] = *(const u32x4*)(XBS + (size_t)(bb * 8 + (piece >> 4)) * 512 + g * 128 + (piece & 15) * 8); }
        bf16x8 cfr[4], bfr[4];
#pragma unroll
        for (int ks = 0; ks < 4; ++ks) { cfr[ks] = *(const bf16x8*)(XC + (size_t)(R0 + tf) * 512 + g * 128 + 32 * ks + 8 * fq); bfr[ks] = *(const bf16x8*)(XBS + (size_t)(bb * 8 + tf) * 512 + g * 128 + 32 * ks + 8 * fq); }
        const float Aneg = -__expf(a.in[14][head]), Dsk = a.in[15][head];
        float acs[8], dtv[8]; float run = 0.f;
#pragma unroll
        for (int t = 0; t < 8; ++t) { dtv[t] = __builtin_bit_cast(float, __builtin_amdgcn_readlane(__builtin_bit_cast(int, dtl), t)); run += dtv[t] * Aneg; acs[t] = run; }
        const float last = run, dec = __expf(last);
        float acsl = 0.f, wl = 0.f;
#pragma unroll
        for (int t = 0; t < 8; ++t) if (lane == t) { acsl = acs[t]; wl = __expf(last - acs[t]) * dtv[t]; }
        { float xv[8]; unpack8(xr, xv);
          *(LAS f32x4*)(sxw + jx * 64 + ox * 8) = (f32x4){xv[0], xv[1], xv[2], xv[3]}; *(LAS f32x4*)(sxw + jx * 64 + ox * 8 + 4) = (f32x4){xv[4], xv[5], xv[6], xv[7]}; }
#pragma unroll
        for (int k = 0; k < 2; ++k) { const int piece = lane + 64 * k, j = piece >> 4, oct = piece & 15; const float wj = __shfl(wl, j); float bv[8]; unpack8(br[k], bv);
            *(LAS f32x4*)(sbw + j * 128 + oct * 8) = (f32x4){bv[0] * wj, bv[1] * wj, bv[2] * wj, bv[3] * wj}; *(LAS f32x4*)(sbw + j * 128 + oct * 8 + 4) = (f32x4){bv[4] * wj, bv[5] * wj, bv[6] * wj, bv[7] * wj}; }
        f32x4 gacc = (f32x4){0.f, 0.f, 0.f, 0.f};
#pragma unroll
        for (int ks = 0; ks < 4; ++ks) gacc = MFMA16(cfr[ks], bfr[ks], gacc);
        float ea[4];
        { const float aj = __shfl(acsl, tf), dj = __shfl(dtl, tf);
#pragma unroll
          for (int r = 0; r < 4; ++r) { const int i = (4 * fq + r) & 7; const float ai = __shfl(acsl, i); ea[r] = __expf(ai);
              const float val = (fr <= i) ? gacc[r] * __expf(ai - aj) * dj : 0.f;
              if (fq < 2 && fr < 8) satt[i * 8 + fr] = val; } }
        WAVE_LDS_SYNC();
#define SMP_PROCESS_H(hh) do { \
        f32x4 yacc[2]; yacc[0] = (f32x4){0.f, 0.f, 0.f, 0.f}; yacc[1] = yacc[0]; \
        _Pragma("unroll") for (int ks = 0; ks < 4; ++ks) _Pragma("unroll") for (int q = 0; q < 2; ++q) { u32x4 hw; hw.x = cvt_pk_bf16(h[q][ks][0][0], h[q][ks][0][1]); hw.y = cvt_pk_bf16(h[q][ks][0][2], h[q][ks][0][3]); \
                hw.z = cvt_pk_bf16(h[q][ks][1][0], h[q][ks][1][1]); hw.w = cvt_pk_bf16(h[q][ks][1][2], h[q][ks][1][3]); \
                yacc[q] = MFMA16(cfr[ks], __builtin_bit_cast(bf16x8, hw), yacc[q]); } \
        if (fq < 2) { _Pragma("unroll") for (int r = 0; r < 4; ++r) { const int i = 4 * fq + r; \
                _Pragma("unroll") for (int q = 0; q < 2; ++q) { const int p = 16 * (2 * (hh) + q) + fr; float y = ea[r] * yacc[q][r]; \
                    _Pragma("unroll") for (int j = 0; j < 8; ++j) y += satt[i * 8 + j] * sxw[j * 64 + p]; \
                    y += Dsk * sxw[i * 64 + p]; sy[i * 64 + p] = y; } } } \
        _Pragma("unroll") for (int ks = 0; ks < 4; ++ks) { \
            _Pragma("unroll") for (int q = 0; q < 2; ++q) { h[q][ks][0] *= dec; h[q][ks][1] *= dec; } \
            _Pragma("unroll") for (int jh = 0; jh < 2; ++jh) { f32x4 bw[4][2]; \
                _Pragma("unroll") for (int jj = 0; jj < 4; ++jj) { bw[jj][0] = *(const LAS f32x4*)(sbw + (4 * jh + jj) * 128 + 32 * ks + 8 * fq); bw[jj][1] = *(const LAS f32x4*)(sbw + (4 * jh + jj) * 128 + 32 * ks + 8 * fq + 4); } \
                _Pragma("unroll") for (int q = 0; q < 2; ++q) _Pragma("unroll") for (int jj = 0; jj < 4; ++jj) { const float xs = sxw[(4 * jh + jj) * 64 + 16 * (2 * (hh) + q) + fr]; h[q][ks][0] += bw[jj][0] * xs; h[q][ks][1] += bw[jj][1] * xs; } } \
            _Pragma("unroll") for (int q = 0; q < 2; ++q) { float* p_ = so + (16 * (2 * (hh) + q) + fr) * 128 + 32 * ks + 8 * fq; *(f32x4*)p_ = h[q][ks][0]; *(f32x4*)(p_ + 4) = h[q][ks][1]; } } } while (0)
        SMP_PROCESS_H(0);
        SMP_LOAD_H(1);
        SMP_PROCESS_H(1);
#undef SMP_LOAD_H
#undef SMP_PROCESS_H
        WAVE_LDS_SYNC();
        { const f32x4 y0 = *(const LAS f32x4*)(sy + jx * 64 + ox * 8), y1 = *(const LAS f32x4*)(sy + jx * 64 + ox * 8 + 4); float zv[8]; unpack8(zr, zv);
          const float q0 = y0[0] * zv[0], q1 = y0[1] * zv[1], q2 = y0[2] * zv[2], q3 = y0[3] * zv[3], q4 = y1[0] * zv[4], q5 = y1[1] * zv[5], q6 = y1[2] * zv[6], q7 = y1[3] * zv[7];
          u32x4 w; w.x = cvt_pk_bf16(q0, q1); w.y = cvt_pk_bf16(q2, q3); w.z = cvt_pk_bf16(q4, q5); w.w = cvt_pk_bf16(q6, q7);
          *(u32x4*)(YZ + (size_t)(R0 + jx) * 2048 + head * 64 + ox * 8) = w;
          float ssq = ((q0 * q0 + q1 * q1) + (q2 * q2 + q3 * q3)) + ((q4 * q4 + q5 * q5) + (q6 * q6 + q7 * q7));
          ssq += __shfl_xor(ssq, 1); ssq += __shfl_xor(ssq, 2); ssq += __shfl_xor(ssq, 4);
          if (ox == 0) SSQ[(size_t)(R0 + jx) * 32 + head] = ssq; }
        WAVE_LDS_SYNC();
    }
}

template <int W> __device__ __forceinline__ void pool_d4(const bf16_t* P, const float* spool, int row0, int ccol, float (&dd)[4][8]) {
    float sum[4][8], uu[4][8];
#pragma unroll
    for (int tk = 0; tk < 4; ++tk)
#pragma unroll
        for (int e = 0; e < 8; ++e) sum[tk][e] = 0.f;
    if (row0 < TP) { const int pos0 = row0 & 2047;
        u32x4 rv[W + 3];
#pragma unroll
        for (int d = 0; d < W + 3; ++d) { const int off = d - (W - 1); rv[d] = (pos0 + off >= 0) ? *(const u32x4*)(P + (size_t)(row0 + off) * NPROJ + C_U + ccol) : (u32x4){0u, 0u, 0u, 0u}; }
#pragma unroll
        for (int d = 0; d < W + 3; ++d) { float u[8]; unpack8(rv[d], u);
#pragma unroll
            for (int tk = 0; tk < 4; ++tk) if (d >= tk && d <= tk + W - 1) {
#pragma unroll
                for (int e = 0; e < 8; ++e) sum[tk][e] += u[e];
                if (d == tk + W - 1) {
#pragma unroll
                    for (int e = 0; e < 8; ++e) uu[tk][e] = u[e]; } } }
#pragma unroll
        for (int tk = 0; tk < 4; ++tk) { const int cnt = pos0 + tk + 1 < W ? pos0 + tk + 1 : W; const float inv = 1.f / (float)cnt;
#pragma unroll
            for (int e = 0; e < 8; ++e) dd[tk][e] = sum[tk][e] * inv - uu[tk][e]; } }
    else { const int rr = row0 - TP, bb = rr >> 3, tt0 = rr & 7;
#pragma unroll
        for (int d = 0; d < W + 3; ++d) { const int s_ = tt0 - (W - 1) + d;
            float u[8];
            if (s_ >= 0) unpack8(*(const u32x4*)(P + (size_t)(TP + bb * 8 + s_) * NPROJ + C_U + ccol), u);
            else { const float* sp = spool + (size_t)(bb * 15 + 15 + s_) * 512 + ccol; const f32x4 u0 = *(const f32x4*)sp, u1 = *(const f32x4*)(sp + 4);
#pragma unroll
                for (int e = 0; e < 4; ++e) { u[e] = u0[e]; u[4 + e] = u1[e]; } }
#pragma unroll
            for (int tk = 0; tk < 4; ++tk) if (d >= tk && d <= tk + W - 1) {
#pragma unroll
                for (int e = 0; e < 8; ++e) sum[tk][e] += u[e];
                if (d == tk + W - 1) {
#pragma unroll
                    for (int e = 0; e < 8; ++e) uu[tk][e] = u[e]; } } }
        const float inv = 1.f / (float)W;
#pragma unroll
        for (int tk = 0; tk < 4; ++tk)
#pragma unroll
            for (int e = 0; e < 8; ++e) dd[tk][e] = sum[tk][e] * inv - uu[tk][e]; }
}
__device__ __forceinline__ void pool_items(const Args& a, LAS unsigned char* lds) {
    const int tid = threadIdx.x, lane = tid & 63, wave = tid >> 6, fr = lane & 15, fq = lane >> 4, G = gridDim.x;
    const bf16_t* P = (const bf16_t*)(a.ws + WS_PROJ); const bf16_t* WPW = (const bf16_t*)(a.ws + WS_WPW); bf16_t* PM = (bf16_t*)(a.ws + WS_PM);
    const float* spool = a.in[2]; const float* pscale = a.in[18];
    __syncthreads();
    for (int item = G - 1 - (int)blockIdx.x; item < 544; item += G) {
        const int grp = 3 - item / 136, tile = item % 136, R0 = tile * 128;
        { const int oc = tid & 15, t0 = (tid >> 4) * 4, ccol = grp * 128 + oc * 8; float dd[4][8];
          if (grp == 0) pool_d4<2>(P, spool, R0 + t0, ccol, dd); else if (grp == 1) pool_d4<4>(P, spool, R0 + t0, ccol, dd);
          else if (grp == 2) pool_d4<8>(P, spool, R0 + t0, ccol, dd); else pool_d4<16>(P, spool, R0 + t0, ccol, dd);
#pragma unroll
          for (int tk = 0; tk < 4; ++tk) { u32x4 wv; wv.x = cvt_pk_bf16(dd[tk][0], dd[tk][1]); wv.y = cvt_pk_bf16(dd[tk][2], dd[tk][3]); wv.z = cvt_pk_bf16(dd[tk][4], dd[tk][5]); wv.w = cvt_pk_bf16(dd[tk][6], dd[tk][7]);
              *(LAS u32x4*)(lds + (t0 + tk) * LSTR + oc * 16) = wv; } }
        bf16x8 wf[4][8];
#pragma unroll
        for (int ks = 0; ks < 4; ++ks)
#pragma unroll
            for (int nf = 0; nf < 8; ++nf) wf[ks][nf] = *(const bf16x8*)(WPW + ((size_t)(grp * 128 + 16 * nf + fr) * 128 + 32 * ks + 8 * fq));
        __syncthreads();
        f32x4 acc[8];
#pragma unroll
        for (int nf = 0; nf < 8; ++nf) acc[nf] = (f32x4){0.f, 0.f, 0.f, 0.f};
#pragma unroll
        for (int ks = 0; ks < 4; ++ks) { const bf16x8 df = *(const LAS bf16x8*)(lds + (16 * wave + fr) * LSTR + ks * 64 + fq * 16);
#pragma unroll
            for (int nf = 0; nf < 8; ++nf) acc[nf] = MFMA16(wf[ks][nf], df, acc[nf]); }
        { const size_t row = (size_t)(R0 + 16 * wave + fr);
#pragma unroll
          for (int nf = 0; nf < 8; ++nf) { const int dc = grp * 128 + 16 * nf + 4 * fq;
              const f32x4 sc = *(const f32x4*)(pscale + dc); const u32x2 zz = *(const u32x2*)(P + row * NPROJ + C_ZP + dc);
              u32x2 o; o.x = cvt_pk_bf16(acc[nf][0] * sc[0] * bf_lo(zz.x), acc[nf][1] * sc[1] * bf_hi(zz.x)); o.y = cvt_pk_bf16(acc[nf][2] * sc[2] * bf_lo(zz.y), acc[nf][3] * sc[3] * bf_hi(zz.y));
              *(u32x2*)(PM + row * 512 + dc) = o; } }
        __syncthreads();
    }
}

__device__ __forceinline__ void phase6(const Args& a) {
    const int tid = threadIdx.x, lane = tid & 63, wave = tid >> 6, G = gridDim.x;
    const float* ssp = (const float*)(a.ws + WS_SSP); const float* fg = a.in[22]; const bf16_t* xb = (const bf16_t*)(a.ws + WS_YZ);
    f32x4 gv[4];
#pragma unroll
    for (int j = 0; j < 4; ++j) gv[j] = *(const f32x4*)(fg + 4 * lane + 256 * j);
    for (int r0 = (blockIdx.x * 8 + wave) * 4; r0 < TP; r0 += G * 32) {
        float sv[4]; f32x4 v[4][4];
#pragma unroll
        for (int u = 0; u < 4; ++u) { sv[u] = lane < 16 ? ssp[(size_t)(r0 + u) * 16 + lane] : 0.f;
#pragma unroll
            for (int j = 0; j < 4; ++j) { const u32x2 w = *(const u32x2*)(xb + (size_t)(r0 + u) * 1024 + 4 * lane + 256 * j); v[u][j] = (f32x4){bf_lo(w.x), bf_hi(w.x), bf_lo(w.y), bf_hi(w.y)}; } }
#pragma unroll
        for (int u = 0; u < 4; ++u) { const float rstd = rsqrtf(wave_sum(sv[u]) * (1.f / 1024.f) + EPS);
#pragma unroll
            for (int j = 0; j < 4; ++j) *(f32x4*)(a.out + (size_t)(r0 + u) * 1024 + 4 * lane + 256 * j) = v[u][j] * rstd * gv[j]; }
    }
    for (int row = TP + blockIdx.x * 8 + wave; row < MT; row += G * 8) {
        const float sv = lane < 16 ? ssp[(size_t)row * 16 + lane] : 0.f; f32x4 v[4];
#pragma unroll
        for (int j = 0; j < 4; ++j) { const u32x2 w = *(const u32x2*)(xb + (size_t)row * 1024 + 4 * lane + 256 * j); v[j] = (f32x4){bf_lo(w.x), bf_hi(w.x), bf_lo(w.y), bf_hi(w.y)}; }
        const float rstd = rsqrtf(wave_sum(sv) * (1.f / 1024.f) + EPS);
#pragma unroll
        for (int j = 0; j < 4; ++j) *(f32x4*)(a.out + (size_t)row * 1024 + 4 * lane + 256 * j) = v[j] * rstd * gv[j];
    }
}

__global__ void __launch_bounds__(512, 2) fwd_kernel(Args a) {
    extern __shared__ __attribute__((aligned(16))) unsigned char lds_raw[];
    LAS unsigned char* lds = (LAS unsigned char*)lds_raw;
    cg::grid_group grid = cg::this_grid();
    const int lo = a.ph_lo, hi = a.ph_hi, G = gridDim.x, bid = blockIdx.x;
    unsigned char* ws = a.ws;
#define IN(k) (lo <= (k) && (k) < hi)
    if (lo < 0) grid.sync();
    if (threadIdx.x < 2) ((volatile LAS unsigned*)(lds + LDS_BYTES - 64))[threadIdx.x] = 0u;
    __syncthreads();
    const XcdBarrier bar = xcd_barrier_post((unsigned*)ws, (volatile LAS unsigned*)(lds + LDS_BYTES - 64));
#define SEAM(k) do { if (IN(k) && IN((k) + 1)) xcd_barrier(bar); } while (0)
    if (IN(0)) phase0(a, lds);
    SEAM(0);
    if (IN(1)) phase1(a);
    SEAM(1);
    if (IN(2)) {
        pg8::Gemm g{(const bf16_t*)(ws + WS_H), (const bf16_t*)(ws + WS_WIN), MT, NGEMM, 1024}; pg8::StaticOrder S; S.init(MT, NGEMM, G, bid);
        pg8::EpiProj E{(bf16_t*)(ws + WS_PROJ), (float*)(ws + WS_DT), a.in[13]};
        pg8::gemm_phase<pg8::EpiProj, pg8::StaticOrder, true, true>(lds, g, S, E);
    }
    SEAM(2);
    if (IN(3)) {
        conv_prepass(a, lds);
        acs_prepass(a);
        p3_copies(a);
        pool_items(a, lds);
    }
    SEAM(3);
    if (IN(4)) {
        for (int it = bid; it < 256; it += G) { const int pair = (it & 7) * 4 + (it >> 6), hd = (pair & 3) * 8 + ((it >> 3) & 7);
            ssd_prompt_item(a, lds, pair >> 2, hd); }
        ssd_sample_items(a, lds);
    }
    SEAM(4);
    if (IN(5)) {
        { pg8::Gemm g{(const bf16_t*)(ws + WS_PM), (const bf16_t*)(ws + WS_WP), MT, 1024, 512}; pg8::StaticOrder S; S.init(MT, 1024, G, bid);
          pg8::EpiPoolOut E{(const bf16_t*)(ws + WS_PROJ), (bf16_t*)(ws + WS_H)};
          pg8::gemm_phase<pg8::EpiPoolOut, pg8::StaticOrder, true, true>(lds, g, S, E); }
        { pg8::Gemm g{(const bf16_t*)(ws + WS_YZ), (const bf16_t*)(ws + WS_WS), MT, 1024, 2048}; pg8::StaticOrder S; S.init(MT, 1024, G, bid);
          LAS float* lr = (LAS float*)(lds + 132096); pg8::Unit u0, u1; const bool h0 = S.next(0, u0), h1 = S.next(1, u1);
          { const int k = threadIdx.x, which = k >> 8; if (which == 0 ? h0 : h1) { const size_t row = (size_t)(which ? u1.pm : u0.pm) * 256 + (k & 255); const float* sq = (const float*)(ws + WS_SSQ) + row * 32;
                f32x4 s4 = (f32x4){0.f, 0.f, 0.f, 0.f};
#pragma unroll
                for (int q = 0; q < 8; ++q) s4 += *(const f32x4*)(sq + 4 * q);
                lr[k] = rsqrtf(((s4[0] + s4[1]) + (s4[2] + s4[3])) * (1.f / 2048.f) + EPS); } }
          __syncthreads();
          pg8::EpiSsmOut E{(const bf16_t*)(ws + WS_PROJ), (bf16_t*)(ws + WS_H), lr, h0 ? u0.pm : -1};
          pg8::gemm_phase<pg8::EpiSsmOut, pg8::StaticOrder, true, true>(lds, g, S, E); }
    }
    SEAM(5);
    if (IN(6)) {
        pg8::Gemm g{(const bf16_t*)(ws + WS_H), (const bf16_t*)(ws + WS_WO), MT, 1024, 1024}; pg8::StaticOrder S; S.init(MT, 1024, G, bid);
        pg8::EpiOut E{a.in[0], a.in[1], (const float*)(ws + WS_GATE), (bf16_t*)(ws + WS_YZ), (float*)(ws + WS_SSP)};
        pg8::gemm_phase<pg8::EpiOut, pg8::StaticOrder, true, true>(lds, g, S, E);
    }
    SEAM(6);
    if (IN(7)) phase6(a);
#undef IN
#undef SEAM
}

#ifndef N_LAUNCHES
#define N_LAUNCHES 1
#endif
extern "C" void kernel_launch(void* const* d_in, const int* in_sizes, int n_in, void* d_out, int out_size, void* d_ws, size_t ws_size, hipStream_t stream) {
    static int grid = 0;
    if (grid == 0) {
        if (n_in != 23 || ws_size < WS_END) { fprintf(stderr, "kernel_launch: unexpected n_in %d / ws_size %zu\n", n_in, ws_size); grid = -1; return; }
        int dev = 0, cus = 0, per_cu = 0;
        hipGetDevice(&dev); hipDeviceGetAttribute(&cus, hipDeviceAttributeMultiprocessorCount, dev);
        if (hipFuncSetAttribute((const void*)fwd_kernel, hipFuncAttributeMaxDynamicSharedMemorySize, LDS_BYTES) != hipSuccess) { fprintf(stderr, "kernel_launch: hipFuncSetAttribute failed\n"); grid = -1; return; }
        if (hipOccupancyMaxActiveBlocksPerMultiprocessor(&per_cu, (const void*)fwd_kernel, 512, LDS_BYTES) != hipSuccess || per_cu < 1) { fprintf(stderr, "kernel_launch: occupancy query says %d\n", per_cu); per_cu = 1; }
        (void)hipGetLastError();
        grid = cus > 0 ? cus : 256;
    }
    if (grid < 0) return;
    Args a{};
    for (int i = 0; i < 23; ++i) a.in[i] = (const float*)d_in[i];
    a.out = (float*)d_out; a.ws = (unsigned char*)d_ws;
    if (hipMemsetAsync(d_ws, 0, 16384, stream) != hipSuccess) { fprintf(stderr, "kernel_launch: memset of barrier words failed\n"); return; }
    for (int li = 0; li < N_LAUNCHES; ++li) {
        a.ph_lo = (N_LAUNCHES == 1) ? 0 : li; a.ph_hi = (N_LAUNCHES == 1) ? 8 : li + 1;
        void* args[] = {&a};
        hipError_t e = hipLaunchCooperativeKernel((const void*)fwd_kernel, dim3(grid), dim3(512), args, LDS_BYTES, stream);
        if (e != hipSuccess) { fprintf(stderr, "kernel_launch: cooperative launch failed: %s (grid %d)\n", hipGetErrorString(e), grid); break; }
    }
}
```

```cpp
#include <hip/hip_runtime.h>
#include <hip/hip_cooperative_groups.h>
#include <cstdio>
#include <cstdint>
namespace cg = cooperative_groups;

#define LAS __attribute__((address_space(3)))
typedef unsigned short bf16_t;
typedef short bf16x8 __attribute__((ext_vector_type(8)));
typedef float f32x4 __attribute__((ext_vector_type(4)));
typedef unsigned u32x4 __attribute__((ext_vector_type(4)));
typedef unsigned u32x2 __attribute__((ext_vector_type(2)));

constexpr int TP = 16384, TS = 1024, MT = TP + TS;
constexpr int NPROJ = 8192;
constexpr int NGEMM = 8448;
constexpr int C_U = 0, C_ZP = 512, C_ZS = 1024, C_XBC = 3072, C_GP = 6144, C_GS = 7168;
constexpr float EPS = 1e-6f;
constexpr size_t O_YP = 0, O_YS = 16777216, O_POOLP = 17825792, O_CONVP = 17887232, O_SSMP = 17960960, O_POOLS = 20058112, O_CONVS = 21041152, O_SSMS = 22220800;
constexpr size_t MiB = 1u << 20;
constexpr size_t WS_MODP = 1 * MiB;
constexpr size_t WS_WIN = 8 * MiB;
constexpr size_t WS_H = 26 * MiB;
constexpr size_t WS_XC = 1 * MiB;
constexpr size_t WS_XBS = 18 * MiB;
constexpr size_t WS_GB = 19 * MiB;
constexpr size_t WS_XT = 35 * MiB;
constexpr size_t WS_BT = 99 * MiB;
constexpr size_t WS_XS = 115 * MiB;
constexpr size_t WS_WP = 119 * MiB;
constexpr size_t WS_WS = 120 * MiB;
constexpr size_t WS_WO = 124 * MiB;
constexpr size_t WS_WPW = 126 * MiB;
constexpr size_t WS_DT = 127 * MiB;
constexpr size_t WS_SSQ = 130 * MiB;
constexpr size_t WS_SSP = 133 * MiB;
constexpr size_t WS_GATE = 135 * MiB;
constexpr size_t WS_ACS = 136 * MiB;
constexpr size_t WS_PM = 138 * MiB;
constexpr size_t WS_YZ = 155 * MiB;
constexpr size_t WS_PROJ = 223 * MiB;
constexpr size_t WS_END = 495 * MiB;
constexpr int LDS_BYTES = 160 * 1024;

struct Args { const float* in[23]; float* out; unsigned char* ws; int ph_lo, ph_hi; };

__device__ __forceinline__ unsigned cvt_pk_bf16(float lo, float hi) { unsigned r; asm volatile("v_cvt_pk_bf16_f32 %0, %1, %2" : "=v"(r) : "v"(lo), "v"(hi)); return r; }
__device__ __forceinline__ unsigned f2bf_c(float f) { unsigned u = __builtin_bit_cast(unsigned, f); return (u + 0x7fffu + ((u >> 16) & 1u)) >> 16; }
__device__ __forceinline__ unsigned pk2_c(float lo, float hi) { return f2bf_c(lo) | (f2bf_c(hi) << 16); }
__device__ __forceinline__ float bf_lo(unsigned u) { return __builtin_bit_cast(float, u << 16); }
__device__ __forceinline__ float bf_hi(unsigned u) { return __builtin_bit_cast(float, u & 0xffff0000u); }
__device__ __forceinline__ float bf2f(bf16_t u) { return __builtin_bit_cast(float, (unsigned)u << 16); }
__device__ __forceinline__ float wave_sum(float v) {
#pragma unroll
    for (int o = 1; o < 64; o <<= 1) v += __shfl_xor(v, o);
    return v;
}
__device__ __forceinline__ float sigmoidf_(float v) { return __builtin_amdgcn_rcpf(1.f + __expf(-v)); }
__device__ __forceinline__ float siluf_(float v) { return v * sigmoidf_(v); }
__device__ __forceinline__ void unpack8(u32x4 v, float* o) { o[0] = bf_lo(v.x); o[1] = bf_hi(v.x); o[2] = bf_lo(v.y); o[3] = bf_hi(v.y); o[4] = bf_lo(v.z); o[5] = bf_hi(v.z); o[6] = bf_lo(v.w); o[7] = bf_hi(v.w); }

namespace pg8 {
constexpr int BM = 256, BK = 64, HALF = 128, HTB = HALF * BK * 2, STAGE_BYTES = 8 * HTB, NXCD = 8, WGM = 4;
__host__ __device__ __forceinline__ int lds_byte(int r, int c) { const int st = (r >> 4) * 2 + (c >> 5), rr = r & 15, cc = c & 31, ob = rr * 64 + cc * 2; return st * 1024 + (ob ^ (((ob >> 9) & 1) << 5)); }
__host__ __device__ __forceinline__ void stage_rc(int b, int& R, int& C) { const int st = b / 1024, sb = b % 1024, swz = sb ^ (((sb >> 9) & 1) << 5); R = (st >> 1) * 16 + swz / 64; C = (st & 1) * 32 + (swz % 64) / 2; }
__host__ __device__ __forceinline__ int perm32(int rho) { const int n = rho >> 4, i = rho & 15; return 8 * (i >> 2) + 4 * n + (i & 3); }
struct Unit { int pm, pn; };
struct Gemm { const bf16_t* A; const bf16_t* Bt; int M, N, K; };
struct StaticOrder {
    int nM, nN, nwg, G, c;
    __host__ __device__ void init(int M, int N, int G_, int c_) { nM = M / BM; nN = N / BM; nwg = nM * nN; G = G_; c = c_; }
    __host__ __device__ bool next(int i, Unit& u) const {
        const long L = (long)i * G + c; if (L >= nwg) return false;
        int wgid = (int)L; { const int q = nwg / NXCD, r = nwg % NXCD, xcd = wgid % NXCD, off = wgid / NXCD; wgid = (xcd < r ? xcd * (q + 1) : r * (q + 1) + (xcd - r) * q) + off; }
        const int nig = WGM * nN, gid = wgid / nig, fm = gid * WGM, gsz = (nM - fm) < WGM ? (nM - fm) : WGM;
        u.pm = fm + ((wgid % nig) % gsz); u.pn = (wgid % nig) / gsz; return true;
    }
    __device__ __forceinline__ void a_ready(const Unit&) const {}
    __device__ __forceinline__ void done(const Unit&) const {}
};

template <class Epi, class Sched, bool ALIGN_EPI = false, bool SP2 = false>
__device__ __forceinline__ void gemm_phase(LAS unsigned char* lds, const Gemm g, const Sched& S, const Epi& E) {
    const int tid = threadIdx.x, wid = __builtin_amdgcn_readfirstlane(tid >> 6), lane = tid & 63, wr = wid >> 2, wc = wid & 3, fr = lane & 15, fq = lane >> 4;
    const int K = g.K, nt = K / BK;
    unsigned voffA[2], voffB[2];
#pragma unroll
    for (int i = 0; i < 2; ++i) { int R, C; stage_rc(tid * 16 + i * 8192, R, C); const int Rb = Epi::PERM ? ((R & ~31) + perm32(R & 31)) : R;
        voffA[i] = (unsigned)(R * K + C) * 2u; voffB[i] = (unsigned)(Rb * K + C) * 2u; }
    const size_t kstep = (size_t)(BK * 2);
    const size_t hstep = (size_t)HALF * K * 2;
    const size_t tstep = 2 * hstep;
    const unsigned ldsw = (unsigned)wid * 1024u;
    const int aoff = lds_byte(wr * 64 + fr, fq * 8), boff = lds_byte(wc * 32 + fr, fq * 8);
#define PG8_SA(b, h) (((b) * 2 + (h)) * HTB)
#define PG8_SB(b, h) ((4 + (b) * 2 + (h)) * HTB)
#define PG8_STAGE(bufoff, gbase, voff) do { _Pragma("unroll") for (int _i = 0; _i < 2; ++_i) \
        __builtin_amdgcn_global_load_lds((const unsigned*)((const char*)(gbase) + (voff)[_i]), (LAS unsigned*)(lds + (bufoff) + ldsw + _i * 8192), 16, 0, 0); } while (0)
#define PG8_LDA(dst, b, h) do { _Pragma("unroll") for (int m = 0; m < 4; ++m) _Pragma("unroll") for (int k = 0; k < 2; ++k) dst[m][k] = *(const LAS bf16x8*)(lds + PG8_SA(b, h) + aoff + m * 2048 + k * 1024); } while (0)
#define PG8_LDB(dst, b, h) do { _Pragma("unroll") for (int n = 0; n < 2; ++n) _Pragma("unroll") for (int k = 0; k < 2; ++k) dst[n][k] = *(const LAS bf16x8*)(lds + PG8_SB(b, h) + boff + n * 2048 + k * 1024); } while (0)
#define PG8_MMA(ai, bj, At, Bt) do { __builtin_amdgcn_s_setprio(1); _Pragma("unroll") for (int m = 0; m < 4; ++m) _Pragma("unroll") for (int n = 0; n < 2; ++n) _Pragma("unroll") for (int k = 0; k < 2; ++k) \
        acc[ai][bj][m][n] = __builtin_amdgcn_mfma_f32_16x16x32_bf16(Bt[n][k], At[m][k], acc[ai][bj][m][n], 0, 0, 0); __builtin_amdgcn_s_setprio(0); } while (0)
#define PG8_WAIT_V(n) asm volatile("s_waitcnt vmcnt(" #n ")" ::: "memory")
#define PG8_WAIT_L(n) asm volatile("s_waitcnt lgkmcnt(" #n ")" ::: "memory")
#define PG8_BAR __builtin_amdgcn_s_barrier()
#define PG8_SCHED __builtin_amdgcn_sched_barrier(0)
    Unit cur, nxt; int ui = 0;
    if (!S.next(0, cur)) return;
    f32x4 acc[2][2][4][2];
#pragma unroll
    for (int a = 0; a < 2; ++a)
#pragma unroll
        for (int b = 0; b < 2; ++b)
#pragma unroll
            for (int m = 0; m < 4; ++m)
#pragma unroll
                for (int n = 0; n < 2; ++n) acc[a][b][m][n] = (f32x4){0.f, 0.f, 0.f, 0.f};
    bf16x8 At[4][2], B0[2][2], B1[2][2];
    const char* cA = (const char*)g.A + (size_t)cur.pm * tstep; const char* cB = (const char*)g.Bt + (size_t)cur.pn * tstep;
    S.a_ready(cur);
    if constexpr (SP2) {
        PG8_STAGE(PG8_SB(0, 0), cB, voffB); PG8_STAGE(PG8_SB(0, 1), cB + hstep, voffB); PG8_STAGE(PG8_SA(0, 0), cA, voffA); PG8_STAGE(PG8_SA(0, 1), cA + hstep, voffA);
        if (wr == 1) PG8_BAR;
        PG8_WAIT_V(2); PG8_BAR;
        PG8_STAGE(PG8_SB(1, 0), cB + kstep, voffB); PG8_STAGE(PG8_SA(1, 0), cA + kstep, voffA); PG8_STAGE(PG8_SB(1, 1), cB + hstep + kstep, voffB);
        PG8_WAIT_V(6); PG8_BAR;
    } else {
        PG8_STAGE(PG8_SB(0, 0), cB, voffB); PG8_STAGE(PG8_SA(0, 0), cA, voffA); PG8_STAGE(PG8_SB(0, 1), cB + hstep, voffB); PG8_STAGE(PG8_SA(0, 1), cA + hstep, voffA);
        if (wr == 1) PG8_BAR;
        PG8_WAIT_V(4); PG8_BAR;
        PG8_STAGE(PG8_SB(1, 0), cB + kstep, voffB); PG8_STAGE(PG8_SA(1, 0), cA + kstep, voffA); PG8_STAGE(PG8_SB(1, 1), cB + hstep + kstep, voffB);
        PG8_WAIT_V(6); PG8_BAR;
    }
    for (;;) {
        const bool has_next = S.next(ui + 1, nxt);
        const char* nA = has_next ? (const char*)g.A + (size_t)nxt.pm * tstep : cA; const char* nB = has_next ? (const char*)g.Bt + (size_t)nxt.pn * tstep : cB;
        for (int t = 0; t < nt; t += 2) {
            const bool last = (t == nt - 2);
            const char* a1 = cA + (size_t)(t + 1) * kstep;
            const char* a2 = last ? nA : cA + (size_t)(t + 2) * kstep; const char* b2 = last ? nB : cB + (size_t)(t + 2) * kstep;
            const char* a3 = a2 + kstep; const char* b3 = b2 + kstep;
            if (last && has_next) S.a_ready(nxt);
            if constexpr (SP2) {
            PG8_LDB(B0, 0, 0); PG8_LDB(B1, 0, 1); PG8_SCHED; PG8_LDA(At, 0, 0); PG8_STAGE(PG8_SA(1, 1), a1 + hstep, voffA);
            PG8_WAIT_V(8); PG8_WAIT_L(0); PG8_BAR; PG8_MMA(0, 0, At, B0); PG8_MMA(0, 1, At, B1); PG8_BAR; PG8_SCHED;
            PG8_LDA(At, 0, 1); PG8_STAGE(PG8_SB(0, 0), b2, voffB); PG8_STAGE(PG8_SB(0, 1), b2 + hstep, voffB); PG8_STAGE(PG8_SA(0, 0), a2, voffA);
            PG8_WAIT_V(8); PG8_WAIT_L(0); PG8_BAR; PG8_MMA(1, 0, At, B0); PG8_MMA(1, 1, At, B1); PG8_BAR; PG8_SCHED;
            PG8_LDB(B0, 1, 0); PG8_LDB(B1, 1, 1); PG8_SCHED; PG8_LDA(At, 1, 0); PG8_STAGE(PG8_SA(0, 1), a2 + hstep, voffA);
            PG8_WAIT_V(8); PG8_WAIT_L(0); PG8_BAR; PG8_MMA(0, 0, At, B0); PG8_MMA(0, 1, At, B1); PG8_BAR; PG8_SCHED;
            PG8_LDA(At, 1, 1); PG8_STAGE(PG8_SB(1, 0), b3, voffB); PG8_STAGE(PG8_SB(1, 1), b3 + hstep, voffB); PG8_STAGE(PG8_SA(1, 0), a3, voffA);
            PG8_WAIT_V(8); PG8_WAIT_L(0); PG8_BAR; PG8_MMA(1, 0, At, B0); PG8_MMA(1, 1, At, B1); PG8_BAR; PG8_SCHED;
            } else {
            PG8_LDB(B0, 0, 0); PG8_SCHED; PG8_LDA(At, 0, 0); PG8_STAGE(PG8_SA(1, 1), a1 + hstep, voffA);
            PG8_WAIT_L(8); PG8_BAR; PG8_WAIT_L(0); PG8_MMA(0, 0, At, B0); PG8_BAR; PG8_SCHED;
            PG8_LDB(B1, 0, 1); PG8_STAGE(PG8_SB(0, 0), b2, voffB);
            PG8_BAR; PG8_WAIT_L(0); PG8_MMA(0, 1, At, B1); PG8_BAR;
            PG8_LDA(At, 0, 1); PG8_STAGE(PG8_SA(0, 0), a2, voffA);
            PG8_BAR; PG8_WAIT_L(0); PG8_MMA(1, 0, At, B0); PG8_BAR; PG8_SCHED;
            PG8_STAGE(PG8_SB(0, 1), b2 + hstep, voffB);
            PG8_WAIT_V(6); PG8_BAR; PG8_MMA(1, 1, At, B1); PG8_BAR;
            PG8_LDB(B0, 1, 0); PG8_SCHED; PG8_LDA(At, 1, 0); PG8_STAGE(PG8_SA(0, 1), a2 + hstep, voffA);
            PG8_WAIT_L(8); PG8_BAR; PG8_WAIT_L(0); PG8_MMA(0, 0, At, B0); PG8_BAR; PG8_SCHED;
            PG8_LDB(B1, 1, 1); PG8_STAGE(PG8_SB(1, 0), b3, voffB);
            PG8_BAR; PG8_WAIT_L(0); PG8_MMA(0, 1, At, B1); PG8_BAR;
            PG8_LDA(At, 1, 1); PG8_STAGE(PG8_SA(1, 0), a3, voffA);
            PG8_BAR; PG8_WAIT_L(0); PG8_MMA(1, 0, At, B0); PG8_BAR; PG8_SCHED;
            PG8_STAGE(PG8_SB(1, 1), b3 + hstep, voffB);
            PG8_WAIT_V(6); PG8_BAR; PG8_MMA(1, 1, At, B1); PG8_BAR;
            }
        }
        if constexpr (ALIGN_EPI) { if (wr == 0) PG8_BAR; }
        if constexpr (!Epi::AFTER_DRAIN) { E(acc, cur, wr, wc, fr, fq); S.done(cur); }
        if (!has_next) break;
#pragma unroll
        for (int a = 0; a < 2; ++a)
#pragma unroll
            for (int b = 0; b < 2; ++b)
#pragma unroll
                for (int m = 0; m < 4; ++m)
#pragma unroll
                    for (int n = 0; n < 2; ++n) acc[a][b][m][n] = (f32x4){0.f, 0.f, 0.f, 0.f};
        cur = nxt; cA = nA; cB = nB; ++ui;
        if constexpr (ALIGN_EPI) { if (wr == 1) PG8_BAR; }
    }
    PG8_WAIT_V(0);
    if constexpr (!ALIGN_EPI) { if (wr == 0) PG8_BAR; }
    PG8_BAR;
#undef PG8_SA
#undef PG8_SB
#undef PG8_STAGE
#undef PG8_LDA
#undef PG8_LDB
#undef PG8_MMA
#undef PG8_WAIT_V
#undef PG8_WAIT_L
#undef PG8_BAR
#undef PG8_SCHED
}

struct EpiProj {
    static constexpr bool PERM = true, AFTER_DRAIN = false;
    bf16_t* P; float* DT; const float* dt_bias;
    __device__ __forceinline__ void operator()(const f32x4 (&acc)[2][2][4][2], const Unit& u, int wr, int wc, int fr, int fq) const {
        const int row0 = u.pm * BM + wr * 64 + fr, pn = u.pn;
        if (pn < 32) {
            const int mode = (pn < 2) ? 0 : (pn < 12) ? 1 : (pn < 24) ? 0 : 2;
            const int col0 = pn * BM + wc * 32 + 8 * fq;
#pragma unroll
            for (int ai = 0; ai < 2; ++ai)
#pragma unroll
                for (int m = 0; m < 4; ++m) { bf16_t* rowp = P + (size_t)(row0 + ai * HALF + m * 16) * NPROJ + col0;
#pragma unroll
                    for (int bj = 0; bj < 2; ++bj) { f32x4 v0 = acc[ai][bj][m][0], v1 = acc[ai][bj][m][1];
                        if (mode == 1) {
#pragma unroll
                            for (int j = 0; j < 4; ++j) { v0[j] = siluf_(v0[j]); v1[j] = siluf_(v1[j]); } }
                        else if (mode == 2) {
#pragma unroll
                            for (int j = 0; j < 4; ++j) { v0[j] = sigmoidf_(v0[j]); v1[j] = sigmoidf_(v1[j]); } }
                        u32x4 w; w.x = cvt_pk_bf16(v0[0], v0[1]); w.y = cvt_pk_bf16(v0[2], v0[3]); w.z = cvt_pk_bf16(v1[0], v1[1]); w.w = cvt_pk_bf16(v1[2], v1[3]);
                        *(u32x4*)(rowp + bj * HALF) = w; } }
        } else if (wc == 0) {
            f32x4 bv[2];
#pragma unroll
            for (int n = 0; n < 2; ++n) bv[n] = *(const f32x4*)(dt_bias + 8 * fq + 4 * n);
#pragma unroll
            for (int ai = 0; ai < 2; ++ai)
#pragma unroll
                for (int m = 0; m < 4; ++m) { float* rowp = DT + (size_t)(row0 + ai * HALF + m * 16) * 32 + 8 * fq;
#pragma unroll
                    for (int n = 0; n < 2; ++n) { f32x4 v = acc[ai][0][m][n] + bv[n];
#pragma unroll
                        for (int j = 0; j < 4; ++j) { const float e = __expf(-fabsf(v[j]));
                            const float l = e < 0.0625f ? e * (1.f - e * (0.5f - e * (0.33333334f - e * (0.25f - 0.2f * e)))) : __logf(1.f + e); v[j] = fmaxf(v[j], 0.f) + l; }
                        *(f32x4*)(rowp + 4 * n) = v; } }
        }
    }
};
struct EpiPoolOut {
    static constexpr bool PERM = true, AFTER_DRAIN = false;
    const bf16_t* P; bf16_t* MB;
    __device__ __forceinline__ void operator()(const f32x4 (&acc)[2][2][4][2], const Unit& u, int wr, int wc, int fr, int fq) const {
        const int row0 = u.pm * BM + wr * 64 + fr, col0 = u.pn * BM + wc * 32 + 8 * fq;
#pragma unroll
        for (int ai = 0; ai < 2; ++ai)
#pragma unroll
            for (int m = 0; m < 4; ++m) { const size_t row = (size_t)(row0 + ai * HALF + m * 16);
#pragma unroll
                for (int bj = 0; bj < 2; ++bj) { const int col = col0 + bj * HALF;
                    float gt[8]; unpack8(*(const u32x4*)(P + row * NPROJ + C_GP + col), gt);
                    const f32x4 v0 = acc[ai][bj][m][0], v1 = acc[ai][bj][m][1];
                    u32x4 w; w.x = cvt_pk_bf16(v0[0] * gt[0], v0[1] * gt[1]); w.y = cvt_pk_bf16(v0[2] * gt[2], v0[3] * gt[3]); w.z = cvt_pk_bf16(v1[0] * gt[4], v1[1] * gt[5]); w.w = cvt_pk_bf16(v1[2] * gt[6], v1[3] * gt[7]);
                    *(u32x4*)(MB + row * 1024 + col) = w; } }
    }
};
struct EpiSsmOut {
    static constexpr bool PERM = true, AFTER_DRAIN = false;
    const bf16_t* P; bf16_t* MB; const LAS float* lr; int pm0;
    __device__ __forceinline__ void operator()(const f32x4 (&acc)[2][2][4][2], const Unit& u, int wr, int wc, int fr, int fq) const {
        const int row0 = u.pm * BM + wr * 64 + fr, col0 = u.pn * BM + wc * 32 + 8 * fq;
        const LAS float* lru = lr + (u.pm == pm0 ? 0 : 256) + wr * 64 + fr;
#pragma unroll
        for (int ai = 0; ai < 2; ++ai)
#pragma unroll
            for (int m = 0; m < 4; ++m) { const size_t row = (size_t)(row0 + ai * HALF + m * 16);
                const float rstd = lru[ai * HALF + m * 16];
#pragma unroll
                for (int bj = 0; bj < 2; ++bj) { const int col = col0 + bj * HALF;
                    float gt[8], mv[8]; unpack8(*(const u32x4*)(P + row * NPROJ + C_GS + col), gt); unpack8(*(const u32x4*)(MB + row * 1024 + col), mv);
                    const f32x4 v0 = acc[ai][bj][m][0] * rstd, v1 = acc[ai][bj][m][1] * rstd;
                    u32x4 w; w.x = cvt_pk_bf16(mv[0] + v0[0] * gt[0], mv[1] + v0[1] * gt[1]); w.y = cvt_pk_bf16(mv[2] + v0[2] * gt[2], mv[3] + v0[3] * gt[3]);
                    w.z = cvt_pk_bf16(mv[4] + v1[0] * gt[4], mv[5] + v1[1] * gt[5]); w.w = cvt_pk_bf16(mv[6] + v1[2] * gt[6], mv[7] + v1[3] * gt[7]);
                    *(u32x4*)(MB + row * 1024 + col) = w; } }
    }
};
struct EpiOut {
    static constexpr bool PERM = false, AFTER_DRAIN = false;
    const float* xp; const float* xs; const float* gatef; bf16_t* xb; float* ssp;
    __device__ __forceinline__ void operator()(const f32x4 (&acc)[2][2][4][2], const Unit& u, int wr, int wc, int fr, int fq) const {
        const int row0 = u.pm * BM + wr * 64 + fr, col0 = u.pn * BM + wc * 32 + 4 * fq;
        const bool prompt = u.pm < 64;
        f32x4 gh[2][2];
#pragma unroll
        for (int bj = 0; bj < 2; ++bj)
#pragma unroll
            for (int n = 0; n < 2; ++n) gh[bj][n] = *(const f32x4*)(gatef + (size_t)(prompt ? (u.pm >> 3) : 8) * 1024 + col0 + bj * HALF + n * 16);
#pragma unroll
        for (int ai = 0; ai < 2; ++ai)
#pragma unroll
            for (int m = 0; m < 4; ++m) { const int row = row0 + ai * HALF + m * 16;
                const int b = row < TP ? (row >> 11) : 8 + ((row - TP) >> 3);
                const float* xr = row < TP ? xp + (size_t)row * 1024 : xs + (size_t)(row - TP) * 1024;
                const float* gr = gatef + (size_t)b * 1024;
                float ss = 0.f;
#pragma unroll
                for (int bj = 0; bj < 2; ++bj)
#pragma unroll
                    for (int n = 0; n < 2; ++n) { const int col = col0 + bj * HALF + n * 16;
                        const f32x4 gv = prompt ? gh[bj][n] : *(const f32x4*)(gr + col);
                        const f32x4 o = *(const f32x4*)(xr + col) + gv * acc[ai][bj][m][n];
                        u32x2 w; w.x = cvt_pk_bf16(o[0], o[1]); w.y = cvt_pk_bf16(o[2], o[3]); *(u32x2*)(xb + (size_t)row * 1024 + col) = w;
                        ss += (o[0] * o[0] + o[1] * o[1]) + (o[2] * o[2] + o[3] * o[3]); }
                ss += __shfl_xor(ss, 16); ss += __shfl_xor(ss, 32);
                if (fq == 0) ssp[(size_t)row * 16 + u.pn * 4 + wc] = ss; }
    }
};
}

#define XB_TMO      128
#define XB_XCNT(j)  (256  + 64 * (j))
#define XB_XSUB(j)  (1280 + 64 * (j))
#define XB_XGEN(j)  (2304 + 64 * (j))
#define XB_TOP      3328
#define XB_TOPGEN   3392
#define XCD_BAR_WORDS 3456
#define XB_SPIN_CAP (1u << 18)

__device__ __forceinline__ unsigned xb_ld(unsigned* p)              { return __hip_atomic_load(p, __ATOMIC_RELAXED, __HIP_MEMORY_SCOPE_AGENT); }
__device__ __forceinline__ unsigned xb_add(unsigned* p, unsigned v) { return __hip_atomic_fetch_add(p, v, __ATOMIC_RELAXED, __HIP_MEMORY_SCOPE_AGENT); }
__device__ __forceinline__ unsigned xb_xcc_id() { return (unsigned)__builtin_amdgcn_s_getreg((3 << 11) | 20) & 0xFu; }
#define XB_SPIN(cond, bar) do { unsigned _sp = 0; while (cond) { __builtin_amdgcn_s_sleep(1); \
    if ((++_sp & 255u) == 0u) { if (xb_ld(&(bar)[XB_TMO])) break; if (_sp > XB_SPIN_CAP) { atomicAdd(&(bar)[XB_TMO], 1u); break; } } } } while (0)

struct XcdBarrier {
    unsigned* bar; unsigned x;
    volatile LAS unsigned* st;
};

__device__ __forceinline__ XcdBarrier xcd_barrier_post(unsigned* bar, volatile LAS unsigned* st) {
    XcdBarrier b; b.bar = bar; b.x = xb_xcc_id(); b.st = st;
    if (threadIdx.x == 0) (void)xb_add(&bar[XB_XCNT(b.x)], 1u);
    return b;
}
__device__ __forceinline__ void xcd_barrier_complete(unsigned* bar, unsigned x, unsigned& nloc, unsigned& nx) {
    const unsigned G = gridDim.x * gridDim.y * gridDim.z;
    unsigned sum, cnt, mine, sp = 0u;
    for (;;) {
        sum = 0u; cnt = 0u; mine = 0u;
#pragma unroll
        for (unsigned j = 0; j < 16; ++j) { const unsigned c = xb_ld(&bar[XB_XCNT(j)]); sum += c; cnt += (c > 0u) ? 1u : 0u; mine = (j == x) ? c : mine; }
        if (sum == G) break;
        __builtin_amdgcn_s_sleep(1);
        if ((++sp & 255u) == 0u) { if (xb_ld(&bar[XB_TMO])) break; if (sp > XB_SPIN_CAP) { atomicAdd(&bar[XB_TMO], 1u); break; } }
    }
    nloc = mine > 0u ? mine : 1u; nx = cnt > 0u ? cnt : 1u;
}

__device__ __forceinline__ void xcd_barrier(const XcdBarrier& b) {
    asm volatile("s_waitcnt vmcnt(0)" ::: "memory");
    __syncthreads();
    if (threadIdx.x == 0) {
        unsigned* bar = b.bar;
        __builtin_amdgcn_s_waitcnt(0);
        unsigned nloc = b.st[0], nx = b.st[1];
        if (nloc == 0u) { xcd_barrier_complete(bar, b.x, nloc, nx); b.st[0] = nloc; b.st[1] = nx; }
        const unsigned old = xb_add(&bar[XB_XSUB(b.x)], 1u);
        const unsigned gen = old / nloc;
        if (old + 1u == (gen + 1u) * nloc) {
            __builtin_amdgcn_fence(__ATOMIC_RELEASE, "agent");
            asm volatile("s_waitcnt vmcnt(0)" ::: "memory");
            const unsigned og = xb_add(&bar[XB_TOP], 1u);
            const unsigned tg = og / nx;
            if (og + 1u == (tg + 1u) * nx) xb_add(&bar[XB_TOPGEN], 1u);
            else XB_SPIN(xb_ld(&bar[XB_TOPGEN]) == tg, bar);
            __builtin_amdgcn_fence(__ATOMIC_ACQUIRE, "agent");
            xb_add(&bar[XB_XGEN(b.x)], 1u);
            asm volatile("s_waitcnt vmcnt(0)" ::: "memory");
        } else {
            XB_SPIN(xb_ld(&bar[XB_XGEN(b.x)]) == gen, bar);
            __builtin_amdgcn_fence(__ATOMIC_ACQUIRE, "agent");
            asm volatile("s_waitcnt vmcnt(0)" ::: "memory");
        }
    }
    __syncthreads();
}

constexpr int LSTR = 272;
constexpr int L_C = 0, L_B = 34816, L_BWT = 69632, L_XT = 104448, L_H = 121856, L_SC = 139264;
#define MFMA16(a, b, c) __builtin_amdgcn_mfma_f32_16x16x32_bf16(a, b, c, 0, 0, 0)

__device__ __forceinline__ void p0_transpose_item(const float* W, int K, int N, bf16_t* WT, int kb, int nb, int out_row0, LAS float* scr, int lane, const float* kscale) {
    const int k0 = 64 * kb, n0 = 32 * nb;
    float tv[32];
#pragma unroll
    for (int i = 0; i < 32; ++i) tv[i] = W[(size_t)(k0 + 2 * i + (lane >> 5)) * N + n0 + (lane & 31)];
#pragma unroll
    for (int i = 0; i < 32; ++i) { const int kk = 2 * i + (lane >> 5); float v = tv[i]; if (kscale) v *= kscale[k0 + kk]; scr[kk * 33 + (lane & 31)] = v; }
    asm volatile("s_waitcnt lgkmcnt(0)" ::: "memory");
    const int c = lane & 7;
#pragma unroll
    for (int j = 0; j < 4; ++j) { const int n = (lane >> 3) + 8 * j; const LAS float* s = scr + (8 * c) * 33 + n;
        u32x4 o; o.x = cvt_pk_bf16(s[0 * 33], s[1 * 33]); o.y = cvt_pk_bf16(s[2 * 33], s[3 * 33]); o.z = cvt_pk_bf16(s[4 * 33], s[5 * 33]); o.w = cvt_pk_bf16(s[6 * 33], s[7 * 33]);
        *(u32x4*)(WT + (size_t)(out_row0 + n) * K + k0 + 8 * c) = o; }
    asm volatile("s_waitcnt lgkmcnt(0)" ::: "memory");
}
__device__ __forceinline__ void phase0(const Args& a, LAS unsigned char* lds) {
    const int tid = threadIdx.x, lane = tid & 63, wave = tid >> 6, G = gridDim.x, bid = blockIdx.x;
    unsigned char* ws = a.ws;
    for (int item = bid; item < 192; item += G) {
        const int ks = item & 3, cs = (item >> 2) % 6, rg = item / 24;
        LAS float* sc = (LAS float*)lds;
        __syncthreads();
        for (int e = tid; e < 17 * 256; e += 512) { const int r = e >> 8, k = e & 255, row = rg * 17 + r;
            const float* cp = row < 8 ? a.in[5] + row * 1024 : a.in[6] + (row - 8) * 1024;
            const float v = cp[ks * 256 + k]; sc[e] = v / (1.f + __expf(-v)); }
        __syncthreads();
        const int col = cs * 512 + wave * 64 + lane;
        const float* wp = a.in[7] + (size_t)(ks * 256) * 3072 + col;
        float acc[17];
#pragma unroll
        for (int r = 0; r < 17; ++r) acc[r] = 0.f;
#pragma unroll 1
        for (int k16 = 0; k16 < 16; ++k16) {
            float w[16];
#pragma unroll
            for (int q = 0; q < 16; ++q) w[q] = wp[(size_t)(16 * k16 + q) * 3072];
#pragma unroll
            for (int q4 = 0; q4 < 4; ++q4) {
#pragma unroll
                for (int r = 0; r < 17; ++r) { const f32x4 s = *(const LAS f32x4*)(sc + r * 256 + 16 * k16 + 4 * q4); acc[r] += (s[0] * w[4 * q4] + s[1] * w[4 * q4 + 1]) + (s[2] * w[4 * q4 + 2] + s[3] * w[4 * q4 + 3]); } }
        }
        float* mp = (float*)(ws + WS_MODP) + ((size_t)ks * 136 + rg * 17) * 3072 + col;
#pragma unroll
        for (int r = 0; r < 17; ++r) mp[(size_t)r * 3072] = acc[r];
    }
    __syncthreads();
    { u32x4* z = (u32x4*)(ws + WS_WIN + (size_t)8224 * 1024 * 2); const u32x4 zero = (u32x4){0u, 0u, 0u, 0u};
      for (int e = bid * 512 + tid; e < 224 * 1024 * 2 / 16; e += G * 512) z[e] = zero; }
    LAS float* scr = (LAS float*)(lds + wave * 16384);
    const int tb0 = G > 224 ? 192 : 0;
    if (bid < tb0) return;
    const int gw = (bid - tb0) * 8 + wave, NGW = (G - tb0) * 8;
    constexpr int I_IN = 16 * 257, I_P = 8 * 32, I_S = 32 * 32, I_O = 16 * 32, I_PW = 4 * 8;
    for (int it = gw; it < I_IN + I_P + I_S + I_O + I_PW; it += NGW) {
        int r = it;
        if (r < I_IN) { const int kb = r / 257, nb = r % 257; const int orow = nb < 192 ? 32 * nb : (nb == 192 ? 8192 : 32 * nb - 32);
            p0_transpose_item(a.in[10], 1024, 8224, (bf16_t*)(ws + WS_WIN), kb, nb, orow, scr, lane, nullptr); continue; } r -= I_IN;
        if (r < I_P) { p0_transpose_item(a.in[19], 512, 1024, (bf16_t*)(ws + WS_WP), r / 32, r % 32, 32 * (r % 32), scr, lane, nullptr); continue; } r -= I_P;
        if (r < I_S) { p0_transpose_item(a.in[20], 2048, 1024, (bf16_t*)(ws + WS_WS), r / 32, r % 32, 32 * (r % 32), scr, lane, a.in[16]); continue; } r -= I_S;
        if (r < I_O) { p0_transpose_item(a.in[21], 1024, 1024, (bf16_t*)(ws + WS_WO), r / 32, r % 32, 32 * (r % 32), scr, lane, nullptr); continue; } r -= I_O;
        { const int g = r >> 3, q = r & 7; p0_transpose_item(a.in[17] + (size_t)g * 16384, 128, 128, (bf16_t*)(ws + WS_WPW) + (size_t)g * 16384, q >> 2, q & 3, 32 * (q & 3), scr, lane, nullptr); }
    }
}

__device__ __forceinline__ void phase1(const Args& a) {
    const int tid = threadIdx.x, lane = tid & 63, wave = tid >> 6, G = gridDim.x, bid = blockIdx.x;
    const int gw = bid * 8 + wave, NGW = G * 8;
    const float* modp = (const float*)(a.ws + WS_MODP); const float* b_ada = a.in[8]; const float* ng = a.in[9];
    bf16_t* H = (bf16_t*)(a.ws + WS_H);
    for (int grp = gw; grp < TP / 8; grp += NGW) {
        const int row0 = grp * 8; const int b = row0 < TP ? (row0 >> 11) : 8 + ((row0 - TP) >> 3);
        f32x4 gs[4], sh[4];
#pragma unroll
        for (int j = 0; j < 4; ++j) { const int k = 4 * lane + 256 * j;
            f32x4 shift = *(const f32x4*)(b_ada + k), scale = *(const f32x4*)(b_ada + 1024 + k);
#pragma unroll
            for (int ks = 0; ks < 4; ++ks) { const float* mp = modp + ((size_t)ks * 136 + b) * 3072 + k; shift += *(const f32x4*)mp; scale += *(const f32x4*)(mp + 1024); }
            gs[j] = *(const f32x4*)(ng + k) * (scale + 1.f); sh[j] = shift; }
#pragma unroll 1
        for (int r4 = 0; r4 < 8; r4 += 4) {
            f32x4 v[4][4];
#pragma unroll
            for (int u = 0; u < 4; ++u) { const int row = row0 + r4 + u; const float* xr = row < TP ? a.in[0] + (size_t)row * 1024 : a.in[1] + (size_t)(row - TP) * 1024;
#pragma unroll
                for (int j = 0; j < 4; ++j) v[u][j] = *(const f32x4*)(xr + 4 * lane + 256 * j); }
#pragma unroll
            for (int u = 0; u < 4; ++u) { const int row = row0 + r4 + u; float s = 0.f;
#pragma unroll
                for (int j = 0; j < 4; ++j) s += (v[u][j][0] * v[u][j][0] + v[u][j][1] * v[u][j][1]) + (v[u][j][2] * v[u][j][2] + v[u][j][3] * v[u][j][3]);
                const float rstd = rsqrtf(wave_sum(s) * (1.f / 1024.f) + EPS);
#pragma unroll
                for (int j = 0; j < 4; ++j) { const f32x4 o = v[u][j] * rstd * gs[j] + sh[j]; u32x2 w; w.x = cvt_pk_bf16(o[0], o[1]); w.y = cvt_pk_bf16(o[2], o[3]);
                    *(u32x2*)(H + (size_t)row * 1024 + 4 * lane + 256 * j) = w; } } }
    }
    for (int row = TP + gw; row < MT; row += NGW) {
        const int b = 8 + ((row - TP) >> 3); const float* xr = a.in[1] + (size_t)(row - TP) * 1024;
        f32x4 v[4]; float s = 0.f;
#pragma unroll
        for (int j = 0; j < 4; ++j) { v[j] = *(const f32x4*)(xr + 4 * lane + 256 * j); s += (v[j][0] * v[j][0] + v[j][1] * v[j][1]) + (v[j][2] * v[j][2] + v[j][3] * v[j][3]); }
        const float rstd = rsqrtf(wave_sum(s) * (1.f / 1024.f) + EPS);
#pragma unroll
        for (int j = 0; j < 4; ++j) { const int k = 4 * lane + 256 * j;
            f32x4 shift = *(const f32x4*)(b_ada + k), scale = *(const f32x4*)(b_ada + 1024 + k);
#pragma unroll
            for (int ks = 0; ks < 4; ++ks) { const float* mp = modp + ((size_t)ks * 136 + b) * 3072 + k; shift += *(const f32x4*)mp; scale += *(const f32x4*)(mp + 1024); }
            const f32x4 o = v[j] * rstd * (*(const f32x4*)(ng + k) * (scale + 1.f)) + shift; u32x2 w; w.x = cvt_pk_bf16(o[0], o[1]); w.y = cvt_pk_bf16(o[2], o[3]);
            *(u32x2*)(H + (size_t)row * 1024 + k) = w; }
    }
    float* gatef = (float*)(a.ws + WS_GATE);
    for (int e = bid * 512 + tid; e < 136 * 256; e += G * 512) { const int b = e >> 8, k = (e & 255) * 4;
        f32x4 gt = *(const f32x4*)(b_ada + 2048 + k);
#pragma unroll
        for (int ks = 0; ks < 4; ++ks) gt += *(const f32x4*)(modp + ((size_t)ks * 136 + b) * 3072 + 2048 + k);
        *(f32x4*)(gatef + (size_t)b * 1024 + k) = gt; }
}


__device__ __forceinline__ void p3_copies(const Args& a) {
    const int G = gridDim.x; const bf16_t* P = (const bf16_t*)(a.ws + WS_PROJ); float* out = a.out;
    const float* spool = a.in[2];
    const bool slack = (G == 256); if (slack && (blockIdx.x < 96 || blockIdx.x >= 224)) return;
    const int vb = slack ? (int)blockIdx.x - 96 : (int)blockIdx.x, NB = slack ? 128 : G;
    for (int w = vb * 512 + threadIdx.x; w < 2297856 / 8; w += NB * 512) {
        const int e = w * 8; const bf16_t* src = nullptr; const float* fsrc = nullptr; float* dst;
        if (e < 61440) { const int b = e / 7680, r = (e / 512) % 15, c = e & 511; src = P + (size_t)(b * 2048 + 2033 + r) * NPROJ + C_U + c; dst = out + O_POOLP + e; }
        else if (e < 61440 + 73728) { const int f = e - 61440, b = f / 9216, r = (f / 3072) % 3, c = f % 3072; src = P + (size_t)(b * 2048 + 2045 + r) * NPROJ + C_XBC + c; dst = out + O_CONVP + f; }
        else if (e < 61440 + 73728 + 983040) { const int f = e - 135168, b = f / 7680, r = (f / 512) % 15, c = f & 511; dst = out + O_POOLS + f;
            if (r < 7) fsrc = spool + (size_t)(b * 15 + 8 + r) * 512 + c; else src = P + (size_t)(TP + b * 8 + r - 7) * NPROJ + C_U + c; }
        else { const int f = e - 1118208, b = f / 9216, r = (f / 3072) % 3, c = f % 3072; src = P + (size_t)(TP + b * 8 + 5 + r) * NPROJ + C_XBC + c; dst = out + O_CONVS + f; }
        f32x4 o0, o1;
        if (fsrc) { o0 = *(const f32x4*)fsrc; o1 = *(const f32x4*)(fsrc + 4); }
        else { float u[8]; unpack8(*(const u32x4*)src, u); o0 = (f32x4){u[0], u[1], u[2], u[3]}; o1 = (f32x4){u[4], u[5], u[6], u[7]}; }
        *(f32x4*)dst = o0; *(f32x4*)(dst + 4) = o1;
    }
}

__device__ __forceinline__ void conv_prepass(const Args& a, LAS unsigned char* lds) {
    const int G = gridDim.x; const bf16_t* P = (const bf16_t*)(a.ws + WS_PROJ);
    bf16_t* XC = (bf16_t*)(a.ws + WS_XC); bf16_t* XBS = (bf16_t*)(a.ws + WS_XBS); bf16_t* XT = (bf16_t*)(a.ws + WS_XT); bf16_t* BT = (bf16_t*)(a.ws + WS_BT); bf16_t* XS = (bf16_t*)(a.ws + WS_XS);
    const float* convw = a.in[11]; const float* convb = a.in[12]; const float* sconv = a.in[3];
    for (int tile = blockIdx.x; tile < 136 * 12; tile += G) {
        const int ci = tile / 12, og = tile % 12; const bool samp = ci >= 128;
        const int l32 = threadIdx.x & 31, rl = threadIdx.x >> 5, gq = og - 8;
        const int oc = og < 8 ? og * 32 + l32 : (l32 < 16 ? 256 + gq * 16 + l32 : 320 + gq * 16 + (l32 - 16)), run = (samp ? ci - 128 : ci) * 16 + rl, xcol = oc * 8;
        float cw[4][8], cb[8];
#pragma unroll
        for (int k = 0; k < 4; ++k) { const f32x4 w0 = *(const f32x4*)(convw + k * 3072 + xcol), w1 = *(const f32x4*)(convw + k * 3072 + xcol + 4);
#pragma unroll
            for (int e = 0; e < 4; ++e) { cw[k][e] = w0[e]; cw[k][4 + e] = w1[e]; } }
        { const f32x4 b0 = *(const f32x4*)(convb + xcol), b1 = *(const f32x4*)(convb + xcol + 4);
#pragma unroll
          for (int e = 0; e < 4; ++e) { cb[e] = b0[e]; cb[4 + e] = b1[e]; } }
        const int R0 = samp ? TP + run * 8 : run * 8, pos0 = R0 & 2047;
        u32x4 rawp[11];
#pragma unroll
        for (int d = 0; d < 11; ++d) rawp[d] = (d >= 3 || (!samp && pos0 > 0)) ? *(const u32x4*)(P + (size_t)(R0 - 3 + d) * NPROJ + C_XBC + xcol) : (u32x4){0u, 0u, 0u, 0u};
        float hist[3][8];
#pragma unroll
        for (int d = 0; d < 3; ++d) {
            if (samp) { const float* sp = sconv + (size_t)(run * 3 + d) * 3072 + xcol; const f32x4 h0 = *(const f32x4*)sp, h1 = *(const f32x4*)(sp + 4);
#pragma unroll
                for (int e = 0; e < 4; ++e) { hist[d][e] = h0[e]; hist[d][4 + e] = h1[e]; } }
            else unpack8(rawp[d], hist[d]); }
        u32x4 nat[8]; float tv[8][8];
#pragma unroll
        for (int t = 0; t < 8; ++t) { float v[8];
#pragma unroll
            for (int e = 0; e < 8; ++e) v[e] = cb[e];
#pragma unroll
            for (int k = 0; k < 4; ++k) { float rw[8];
                if (t + k < 3) {
#pragma unroll
                    for (int e = 0; e < 8; ++e) rw[e] = hist[t + k][e]; }
                else unpack8(rawp[t + k], rw);
#pragma unroll
                for (int e = 0; e < 8; ++e) v[e] += cw[k][e] * rw[e]; }
#pragma unroll
            for (int e = 0; e < 8; ++e) { v[e] = siluf_(v[e]); tv[e][t] = v[e]; }
            nat[t].x = cvt_pk_bf16(v[0], v[1]); nat[t].y = cvt_pk_bf16(v[2], v[3]); nat[t].z = cvt_pk_bf16(v[4], v[5]); nat[t].w = cvt_pk_bf16(v[6], v[7]); }
        if (oc >= 256) {
            if (oc >= 320) {
#pragma unroll
                for (int t = 0; t < 8; ++t) *(u32x4*)(XC + (size_t)(R0 + t) * 512 + (oc - 320) * 8) = nat[t]; }
            else if (samp) {
#pragma unroll
                for (int t = 0; t < 8; ++t) *(u32x4*)(XBS + (size_t)(run * 8 + t) * 512 + (oc - 256) * 8) = nat[t]; }
            if (!samp) { const int base = l32 < 16 ? L_B + l32 * 16 : L_C + (l32 - 16) * 16;
#pragma unroll
                for (int t = 0; t < 8; ++t) *(LAS u32x4*)(lds + base + (rl * 8 + t) * LSTR) = nat[t]; } }
        else if (samp) {
#pragma unroll
            for (int t = 0; t < 8; ++t) *(u32x4*)(XS + (size_t)(run * 8 + t) * 2048 + xcol) = nat[t]; }
        if (!samp && oc < 320) {
            const int bc = R0 >> 7, j0 = R0 & 127;
            bf16_t* dst = oc < 256 ? XT + ((size_t)(bc * 32 + (oc >> 3)) * 64 + (oc & 7) * 8) * 128 + j0 : BT + ((size_t)(bc * 4 + ((oc - 256) >> 4)) * 128 + ((oc - 256) & 15) * 8) * 128 + j0;
#pragma unroll
            for (int e = 0; e < 8; ++e) { u32x4 w; w.x = cvt_pk_bf16(tv[e][0], tv[e][1]); w.y = cvt_pk_bf16(tv[e][2], tv[e][3]); w.z = cvt_pk_bf16(tv[e][4], tv[e][5]); w.w = cvt_pk_bf16(tv[e][6], tv[e][7]);
                *(u32x4*)(dst + (size_t)e * 128) = w; } }
        if (og >= 8 && !samp) {
            __syncthreads();
            const int lane = threadIdx.x & 63, wave = threadIdx.x >> 6, fr = lane & 15, fq = lane >> 4, wi = wave >> 1, wj = wave & 1, i0 = 32 * wi, jb0 = 64 * wj;
            f32x4 gacc[2][4];
#pragma unroll
            for (int mi = 0; mi < 2; ++mi)
#pragma unroll
                for (int nj = 0; nj < 4; ++nj) gacc[mi][nj] = (f32x4){0.f, 0.f, 0.f, 0.f};
#pragma unroll
            for (int ks = 0; ks < 4; ++ks) { bf16x8 af[2], bfr[4];
#pragma unroll
                for (int mi = 0; mi < 2; ++mi) af[mi] = *(const LAS bf16x8*)(lds + L_C + (i0 + 16 * mi + fr) * LSTR + ks * 64 + fq * 16);
#pragma unroll
                for (int nj = 0; nj < 4; ++nj) bfr[nj] = *(const LAS bf16x8*)(lds + L_B + (jb0 + 16 * nj + fr) * LSTR + ks * 64 + fq * 16);
#pragma unroll
                for (int mi = 0; mi < 2; ++mi)
#pragma unroll
                    for (int nj = 0; nj < 4; ++nj) gacc[mi][nj] = MFMA16(bfr[nj], af[mi], gacc[mi][nj]); }
            bf16_t* gb = (bf16_t*)(a.ws + WS_GB) + (size_t)(ci * 4 + gq) * 16384;
#pragma unroll
            for (int mi = 0; mi < 2; ++mi)
#pragma unroll
                for (int nj = 0; nj < 4; ++nj) { u32x2 w; w.x = pk2_c(gacc[mi][nj][0], gacc[mi][nj][1]); w.y = pk2_c(gacc[mi][nj][2], gacc[mi][nj][3]);
                    *(u32x2*)(gb + (size_t)(i0 + 16 * mi + fr) * 128 + jb0 + 16 * nj + 4 * fq) = w; }
            __syncthreads();
        }
    }
}
__device__ __forceinline__ void acs_prepass(const Args& a) {
    const int lane = threadIdx.x & 63, wave = threadIdx.x >> 6, G = gridDim.x;
    const bool slack = (G == 256);
    if (slack ? (wave >= 4 || blockIdx.x < 96 || blockIdx.x >= 224) : (wave >= 2)) return;
    const float* DT = (const float*)(a.ws + WS_DT); float* ACS = (float*)(a.ws + WS_ACS);
    const int h8 = lane & 7, seg = lane >> 3;
    for (int wi = slack ? ((int)blockIdx.x - 96) * 4 + wave : (int)blockIdx.x * 2 + wave; wi < 512; wi += slack ? 512 : G * 2) {
        const int ck = wi >> 2, head = (wi & 3) * 8 + h8; const float Aneg = -__expf(a.in[14][head]);
        const float* dp = DT + (size_t)(ck * 128 + 16 * seg) * 32 + head; float* ap = ACS + (size_t)(ck * 128 + 16 * seg) * 32 + head;
        float v[16]; float tot = 0.f;
#pragma unroll
        for (int t = 0; t < 16; ++t) v[t] = dp[t * 32];
#pragma unroll
        for (int t = 0; t < 16; ++t) { v[t] *= Aneg; tot += v[t]; }
        float pre = 0.f;
#pragma unroll
        for (int sgm = 0; sgm < 7; ++sgm) { const float ts = __shfl(tot, h8 + 8 * sgm); if (sgm < seg) pre += ts; }
        float run = pre;
#pragma unroll
        for (int t = 0; t < 16; ++t) { run += v[t]; ap[t * 32] = run; }
    }
}

__device__ __forceinline__ void ssd_prompt_item(const Args& a, LAS unsigned char* lds, int b, int head) {
    const int tid = threadIdx.x, lane = tid & 63, wave = tid >> 6, fr = lane & 15, fq = lane >> 4, g = head >> 3;
    const bf16_t* P = (const bf16_t*)(a.ws + WS_PROJ); const bf16_t* XC = (const bf16_t*)(a.ws + WS_XC); const bf16_t* XT = (const bf16_t*)(a.ws + WS_XT); const bf16_t* BT = (const bf16_t*)(a.ws + WS_BT); const bf16_t* GB = (const bf16_t*)(a.ws + WS_GB);
    const float* DT = (const float*)(a.ws + WS_DT); const float* ACS = (const float*)(a.ws + WS_ACS);
    bf16_t* YZ = (bf16_t*)(a.ws + WS_YZ); float* SSQ = (float*)(a.ws + WS_SSQ);
    const float Dsk = a.in[15][head];
    LAS float* sS = (LAS float*)(lds + L_SC);
    u32x4 pf[14]; u32x2 zf[4]; float pa = 0.f, pd = 0.f;
#define SSD_ISSUE(c_) do { const int R0n = b * 2048 + (c_) * 128, bcn = b * 16 + (c_); \
        if (tid < 128) { pa = ACS[(size_t)(R0n + tid) * 32 + head]; pd = DT[(size_t)(R0n + tid) * 32 + head]; } \
        _Pragma("unroll") for (int i = 0; i < 4; ++i) { const int q = tid + 512 * i; pf[i] = *(const u32x4*)(XC + (size_t)(R0n + (q >> 4)) * 512 + g * 128 + (q & 15) * 8); } \
        _Pragma("unroll") for (int i = 0; i < 4; ++i) { const int q = tid + 512 * i; pf[4 + i] = ((q & 15) * 8 <= (q >> 4)) ? *(const u32x4*)(GB + ((size_t)(bcn * 4 + g) * 128 + (q >> 4)) * 128 + (q & 15) * 8) : (u32x4){0u, 0u, 0u, 0u}; } \
        _Pragma("unroll") for (int i = 0; i < 4; ++i) { const int q = tid + 512 * i; pf[8 + i] = *(const u32x4*)(BT + ((size_t)(bcn * 4 + g) * 128 + (q >> 4)) * 128 + (q & 15) * 8); } \
        _Pragma("unroll") for (int i = 0; i < 2; ++i) { const int q = tid + 512 * i; pf[12 + i] = *(const u32x4*)(XT + ((size_t)(bcn * 32 + head) * 64 + (q >> 4)) * 128 + (q & 15) * 8); } } while (0)
#define SSD_ISSUE_Z(c_) do { const int R0n = b * 2048 + (c_) * 128; \
        _Pragma("unroll") for (int k = 0; k < 4; ++k) zf[k] = *(const u32x2*)(P + (size_t)(R0n + 16 * wave + fr) * NPROJ + C_ZS + head * 64 + 16 * k + 4 * fq); } while (0)
    __syncthreads();
    SSD_ISSUE(0); SSD_ISSUE_Z(0);
    for (int e = tid; e < 64 * LSTR / 16; e += 512) *(LAS u32x4*)(lds + L_H + e * 16) = (u32x4){0u, 0u, 0u, 0u};
    if (tid < 128) { sS[tid] = pa; sS[128 + tid] = pd; }
    __syncthreads();
    f32x4 hacc[4];
#pragma unroll
    for (int k = 0; k < 4; ++k) hacc[k] = (f32x4){0.f, 0.f, 0.f, 0.f};
#pragma unroll 1
    for (int c = 0; c < 16; ++c) {
        const int R0 = b * 2048 + c * 128;
        LAS float* sAcs = sS + (c & 1) * 256; LAS float* sDt = sAcs + 128;
        const float last = sAcs[127];
        { const int jo = tid & 15; float w8[8], aj[8], dj[8];
          { const f32x4 a0 = *(const LAS f32x4*)(sAcs + jo * 8), a1 = *(const LAS f32x4*)(sAcs + jo * 8 + 4), d0 = *(const LAS f32x4*)(sDt + jo * 8), d1 = *(const LAS f32x4*)(sDt + jo * 8 + 4);
#pragma unroll
            for (int e = 0; e < 4; ++e) { aj[e] = a0[e]; aj[4 + e] = a1[e]; dj[e] = d0[e]; dj[4 + e] = d1[e]; }
#pragma unroll
            for (int e = 0; e < 8; ++e) w8[e] = __expf(last - aj[e]) * dj[e]; }
#pragma unroll
          for (int i = 0; i < 4; ++i) { const int q = tid + 512 * i, ii = q >> 4, off = ii * LSTR + jo * 16;
              *(LAS u32x4*)(lds + L_C + off) = pf[i];
              { float gv[8]; unpack8(pf[4 + i], gv); const float ai = sAcs[ii]; float at[8];
#pragma unroll
                for (int e = 0; e < 8; ++e) { const float v = gv[e] * __expf(fminf(ai - aj[e], 0.f)) * dj[e]; at[e] = (jo * 8 + e <= ii) ? v : 0.f; }
                u32x4 w; w.x = cvt_pk_bf16(at[0], at[1]); w.y = cvt_pk_bf16(at[2], at[3]); w.z = cvt_pk_bf16(at[4], at[5]); w.w = cvt_pk_bf16(at[6], at[7]);
                *(LAS u32x4*)(lds + L_B + off) = w; }
              float bv[8]; unpack8(pf[8 + i], bv); u32x4 w; w.x = cvt_pk_bf16(bv[0] * w8[0], bv[1] * w8[1]); w.y = cvt_pk_bf16(bv[2] * w8[2], bv[3] * w8[3]); w.z = cvt_pk_bf16(bv[4] * w8[4], bv[5] * w8[5]); w.w = cvt_pk_bf16(bv[6] * w8[6], bv[7] * w8[7]);
              *(LAS u32x4*)(lds + L_BWT + off) = w; }
#pragma unroll
          for (int i = 0; i < 2; ++i) { const int q = tid + 512 * i; *(LAS u32x4*)(lds + L_XT + (q >> 4) * LSTR + jo * 16) = pf[12 + i]; } }
        if (c + 1 < 16) SSD_ISSUE(c + 1);
        __syncthreads();
        const int irow = 16 * wave + fr, ilast = __builtin_amdgcn_readfirstlane(16 * wave + 15);
        f32x4 yacc[4];
#pragma unroll
        for (int k = 0; k < 4; ++k) yacc[k] = (f32x4){0.f, 0.f, 0.f, 0.f};
#pragma unroll
        for (int ks = 0; ks < 4; ++ks) { const bf16x8 cf = *(const LAS bf16x8*)(lds + L_C + irow * LSTR + ks * 64 + fq * 16);
#pragma unroll
            for (int k = 0; k < 4; ++k) { const bf16x8 hf = *(const LAS bf16x8*)(lds + L_H + (16 * k + fr) * LSTR + ks * 64 + fq * 16); yacc[k] = MFMA16(hf, cf, yacc[k]); } }
        { const float ea = __expf(sAcs[irow]), dec = __expf(last);
#pragma unroll
          for (int k = 0; k < 4; ++k) { yacc[k] *= ea; hacc[k] *= dec; } }
#pragma unroll
        for (int ks = 0; ks < 4; ++ks) { const bf16x8 af = *(const LAS bf16x8*)(lds + L_B + irow * LSTR + ks * 64 + fq * 16);
            const bf16x8 bwf = *(const LAS bf16x8*)(lds + L_BWT + irow * LSTR + ks * 64 + fq * 16);
#pragma unroll
            for (int k = 0; k < 4; ++k) { const bf16x8 xf = *(const LAS bf16x8*)(lds + L_XT + (16 * k + fr) * LSTR + ks * 64 + fq * 16);
                if (32 * ks <= ilast) yacc[k] = MFMA16(xf, af, yacc[k]);
                hacc[k] = MFMA16(xf, bwf, hacc[k]); } }
        { const size_t row = (size_t)(R0 + irow); float ssq = 0.f;
#pragma unroll
          for (int k = 0; k < 4; ++k) { const int p0 = 16 * k + 4 * fq; const u32x2 zz = zf[k];
              float yz[4];
#pragma unroll
              for (int r = 0; r < 4; ++r) { const float xv = bf2f(*(const LAS unsigned short*)(lds + L_XT + (p0 + r) * LSTR + irow * 2));
                  const float z = r == 0 ? bf_lo(zz.x) : r == 1 ? bf_hi(zz.x) : r == 2 ? bf_lo(zz.y) : bf_hi(zz.y);
                  yz[r] = (yacc[k][r] + Dsk * xv) * z; ssq += yz[r] * yz[r]; }
              u32x2 w; w.x = cvt_pk_bf16(yz[0], yz[1]); w.y = cvt_pk_bf16(yz[2], yz[3]);
              *(u32x2*)(YZ + row * 2048 + head * 64 + p0) = w; }
          ssq += __shfl_xor(ssq, 16); ssq += __shfl_xor(ssq, 32);
          if (fq == 0) SSQ[row * 32 + head] = ssq; }
        if (c + 1 < 16) SSD_ISSUE_Z(c + 1);
        if (tid < 128 && c + 1 < 16) { LAS float* nS = sS + ((c + 1) & 1) * 256; nS[tid] = pa; nS[128 + tid] = pd; }
        __syncthreads();
#pragma unroll
        for (int k = 0; k < 4; ++k)
#pragma unroll
            for (int r = 0; r < 4; ++r) *(LAS unsigned short*)(lds + L_H + (16 * k + 4 * fq + r) * LSTR + (16 * wave + fr) * 2) = (unsigned short)(cvt_pk_bf16(hacc[k][r], 0.f) & 0xffffu);
    }
#undef SSD_ISSUE
#undef SSD_ISSUE_Z
    float* so = a.out + O_SSMP + (size_t)(b * 32 + head) * 8192;
#pragma unroll
    for (int k = 0; k < 4; ++k)
#pragma unroll
        for (int r = 0; r < 4; ++r) so[(16 * k + 4 * fq + r) * 128 + 16 * wave + fr] = hacc[k][r];
}

#define WAVE_LDS_SYNC() asm volatile("s_waitcnt lgkmcnt(0)" ::: "memory")
__device__ __forceinline__ void ssd_sample_items(const Args& a, LAS unsigned char* lds) {
    const int tid = threadIdx.x, lane = tid & 63, wave = tid >> 6, fr = lane & 15, fq = lane >> 4, G = gridDim.x;
    const bf16_t* P = (const bf16_t*)(a.ws + WS_PROJ); const bf16_t* XC = (const bf16_t*)(a.ws + WS_XC); const bf16_t* XBS = (const bf16_t*)(a.ws + WS_XBS); const bf16_t* XS = (const bf16_t*)(a.ws + WS_XS); const float* DT = (const float*)(a.ws + WS_DT);
    bf16_t* YZ = (bf16_t*)(a.ws + WS_YZ); float* SSQ = (float*)(a.ws + WS_SSQ); const float* sssm = a.in[4];
    LAS float* sxw = (LAS float*)(lds + wave * 9216); LAS float* sbw = sxw + 512; LAS float* satt = sbw + 1024; LAS float* sy = satt + 64;
    const int jx = lane >> 3, ox = lane & 7, tf = fr & 7;
    __syncthreads();
#pragma unroll 1
    for (int item = blockIdx.x * 8 + wave; item < 4096; item += G * 8) {
        const int bb = item >> 5, head = item & 31, g = head >> 3, R0 = TP + bb * 8;
        const float* hp = sssm + (size_t)item * 8192; float* so = a.out + O_SSMS + (size_t)item * 8192;
        f32x4 h[2][4][2];
#define SMP_LOAD_H(hh) do { _Pragma("unroll") for (int q = 0; q < 2; ++q) _Pragma("unroll") for (int ks = 0; ks < 4; ++ks) { \
            const float* p_ = hp + (16 * (2 * (hh) + q) + fr) * 128 + 32 * ks + 8 * fq; h[q][ks][0] = *(const f32x4*)p_; h[q][ks][1] = *(const f32x4*)(p_ + 4); } } while (0)
        SMP_LOAD_H(0);
        const float dtl = lane < 8 ? DT[(size_t)(R0 + lane) * 32 + head] : 0.f;
        const u32x4 xr = *(const u32x4*)(XS + (size_t)(bb * 8 + jx) * 2048 + head * 64 + ox * 8);
        const u32x4 zr = *(const u32x4*)(P + (size_t)(R0 + jx) * NPROJ + C_ZS + head * 64 + ox * 8);
        u32x4 br[2];
#pragma unroll
        for (int k = 0; k < 2; ++k) { const int piece = lane + 64 * k; br[k] = *(const u32x4*)(XBS + (size_t)(bb * 8 + (piece >> 4)) * 512 + g * 128 + (piece & 15) * 8); }
        bf16x8 cfr[4], bfr[4];
#pragma unroll
        for (int ks = 0; ks < 4; ++ks) { cfr[ks] = *(const bf16x8*)(XC + (size_t)(R0 + tf) * 512 + g * 128 + 32 * ks + 8 * fq); bfr[ks] = *(const bf16x8*)(XBS + (size_t)(bb * 8 + tf) * 512 + g * 128 + 32 * ks + 8 * fq); }
        const float Aneg = -__expf(a.in[14][head]), Dsk = a.in[15][head];
        float acs[8], dtv[8]; float run = 0.f;
#pragma unroll
        for (int t = 0; t < 8; ++t) { dtv[t] = __builtin_bit_cast(float, __builtin_amdgcn_readlane(__builtin_bit_cast(int, dtl), t)); run += dtv[t] * Aneg; acs[t] = run; }
        const float last = run, dec = __expf(last);
        float acsl = 0.f, wl = 0.f;
#pragma unroll
        for (int t = 0; t < 8; ++t) if (lane == t) { acsl = acs[t]; wl = __expf(last - acs[t]) * dtv[t]; }
        { float xv[8]; unpack8(xr, xv);
          *(LAS f32x4*)(sxw + jx * 64 + ox * 8) = (f32x4){xv[0], xv[1], xv[2], xv[3]}; *(LAS f32x4*)(sxw + jx * 64 + ox * 8 + 4) = (f32x4){xv[4], xv[5], xv[6], xv[7]}; }
#pragma unroll
        for (int k = 0; k < 2; ++k) { const int piece = lane + 64 * k, j = piece >> 4, oct = piece & 15; const float wj = __shfl(wl, j); float bv[8]; unpack8(br[k], bv);
            *(LAS f32x4*)(sbw + j * 128 + oct * 8) = (f32x4){bv[0] * wj, bv[1] * wj, bv[2] * wj, bv[3] * wj}; *(LAS f32x4*)(sbw + j * 128 + oct * 8 + 4) = (f32x4){bv[4] * wj, bv[5] * wj, bv[6] * wj, bv[7] * wj}; }
        f32x4 gacc = (f32x4){0.f, 0.f, 0.f, 0.f};
#pragma unroll
        for (int ks = 0; ks < 4; ++ks) gacc = MFMA16(cfr[ks], bfr[ks], gacc);
        float ea[4];
        { const float aj = __shfl(acsl, tf), dj = __shfl(dtl, tf);
#pragma unroll
          for (int r = 0; r < 4; ++r) { const int i = (4 * fq + r) & 7; const float ai = __shfl(acsl, i); ea[r] = __expf(ai);
              const float val = (fr <= i) ? gacc[r] * __expf(ai - aj) * dj : 0.f;
              if (fq < 2 && fr < 8) satt[i * 8 + fr] = val; } }
        WAVE_LDS_SYNC();
#define SMP_PROCESS_H(hh) do { \
        f32x4 yacc[2]; yacc[0] = (f32x4){0.f, 0.f, 0.f, 0.f}; yacc[1] = yacc[0]; \
        _Pragma("unroll") for (int ks = 0; ks < 4; ++ks) _Pragma("unroll") for (int q = 0; q < 2; ++q) { u32x4 hw; hw.x = cvt_pk_bf16(h[q][ks][0][0], h[q][ks][0][1]); hw.y = cvt_pk_bf16(h[q][ks][0][2], h[q][ks][0][3]); \
                hw.z = cvt_pk_bf16(h[q][ks][1][0], h[q][ks][1][1]); hw.w = cvt_pk_bf16(h[q][ks][1][2], h[q][ks][1][3]); \
                yacc[q] = MFMA16(cfr[ks], __builtin_bit_cast(bf16x8, hw), yacc[q]); } \
        if (fq < 2) { _Pragma("unroll") for (int r = 0; r < 4; ++r) { const int i = 4 * fq + r; \
                _Pragma("unroll") for (int q = 0; q < 2; ++q) { const int p = 16 * (2 * (hh) + q) + fr; float y = ea[r] * yacc[q][r]; \
                    _Pragma("unroll") for (int j = 0; j < 8; ++j) y += satt[i * 8 + j] * sxw[j * 64 + p]; \
                    y += Dsk * sxw[i * 64 + p]; sy[i * 64 + p] = y; } } } \
        _Pragma("unroll") for (int ks = 0; ks < 4; ++ks) { \
            _Pragma("unroll") for (int q = 0; q < 2; ++q) { h[q][ks][0] *= dec; h[q][ks][1] *= dec; } \
            _Pragma("unroll") for (int jh = 0; jh < 2; ++jh) { f32x4 bw[4][2]; \
                _Pragma("unroll") for (int jj = 0; jj < 4; ++jj) { bw[jj][0] = *(const LAS f32x4*)(sbw + (4 * jh + jj) * 128 + 32 * ks + 8 * fq); bw[jj][1] = *(const LAS f32x4*)(sbw + (4 * jh + jj) * 128 + 32 * ks + 8 * fq + 4); } \
                _Pragma("unroll") for (int q = 0; q < 2; ++q) _Pragma("unroll") for (int jj = 0; jj < 4; ++jj) { const float xs = sxw[(4 * jh + jj) * 64 + 16 * (2 * (hh) + q) + fr]; h[q][ks][0] += bw[jj][0] * xs; h[q][ks][1] += bw[jj][1] * xs; } } \
            _Pragma("unroll") for (int q = 0; q < 2; ++q) { float* p_ = so + (16 * (2 * (hh) + q) + fr) * 128 + 32 * ks + 8 * fq; *(f32x4*)p_ = h[q][ks][0]; *(f32x4*)(p_ + 4) = h[q][ks][1]; } } } while (0)
        SMP_PROCESS_H(0);
        SMP_LOAD_H(1);
        SMP_PROCESS_H(1);
#undef SMP_LOAD_H
#undef SMP_PROCESS_H
        WAVE_LDS_SYNC();
        { const f32x4 y0 = *(const LAS f32x4*)(sy + jx * 64 + ox * 8), y1 = *(const LAS f32x4*)(sy + jx * 64 + ox * 8 + 4); float zv[8]; unpack8(zr, zv);
          const float q0 = y0[0] * zv[0], q1 = y0[1] * zv[1], q2 = y0[2] * zv[2], q3 = y0[3] * zv[3], q4 = y1[0] * zv[4], q5 = y1[1] * zv[5], q6 = y1[2] * zv[6], q7 = y1[3] * zv[7];
          u32x4 w; w.x = cvt_pk_bf16(q0, q1); w.y = cvt_pk_bf16(q2, q3); w.z = cvt_pk_bf16(q4, q5); w.w = cvt_pk_bf16(q6, q7);
          *(u32x4*)(YZ + (size_t)(R0 + jx) * 2048 + head * 64 + ox * 8) = w;
          float ssq = ((q0 * q0 + q1 * q1) + (q2 * q2 + q3 * q3)) + ((q4 * q4 + q5 * q5) + (q6 * q6 + q7 * q7));
          ssq += __shfl_xor(ssq, 1); ssq += __shfl_xor(ssq, 2); ssq += __shfl_xor(ssq, 4);
          if (ox == 0) SSQ[(size_t)(R0 + jx) * 32 + head] = ssq; }
        WAVE_LDS_SYNC();
    }
}

template <int W> __device__ __forceinline__ void pool_d4(const bf16_t* P, const float* spool, int row0, int ccol, float (&dd)[4][8]) {
    float sum[4][8], uu[4][8];
#pragma unroll
    for (int tk = 0; tk < 4; ++tk)
#pragma unroll
        for (int e = 0; e < 8; ++e) sum[tk][e] = 0.f;
    if (row0 < TP) { const int pos0 = row0 & 2047;
        u32x4 rv[W + 3];
#pragma unroll
        for (int d = 0; d < W + 3; ++d) { const int off = d - (W - 1); rv[d] = (pos0 + off >= 0) ? *(const u32x4*)(P + (size_t)(row0 + off) * NPROJ + C_U + ccol) : (u32x4){0u, 0u, 0u, 0u}; }
#pragma unroll
        for (int d = 0; d < W + 3; ++d) { float u[8]; unpack8(rv[d], u);
#pragma unroll
            for (int tk = 0; tk < 4; ++tk) if (d >= tk && d <= tk + W - 1) {
#pragma unroll
                for (int e = 0; e < 8; ++e) sum[tk][e] += u[e];
                if (d == tk + W - 1) {
#pragma unroll
                    for (int e = 0; e < 8; ++e) uu[tk][e] = u[e]; } } }
#pragma unroll
        for (int tk = 0; tk < 4; ++tk) { const int cnt = pos0 + tk + 1 < W ? pos0 + tk + 1 : W; const float inv = 1.f / (float)cnt;
#pragma unroll
            for (int e = 0; e < 8; ++e) dd[tk][e] = sum[tk][e] * inv - uu[tk][e]; } }
    else { const int rr = row0 - TP, bb = rr >> 3, tt0 = rr & 7;
#pragma unroll
        for (int d = 0; d < W + 3; ++d) { const int s_ = tt0 - (W - 1) + d;
            float u[8];
            if (s_ >= 0) unpack8(*(const u32x4*)(P + (size_t)(TP + bb * 8 + s_) * NPROJ + C_U + ccol), u);
            else { const float* sp = spool + (size_t)(bb * 15 + 15 + s_) * 512 + ccol; const f32x4 u0 = *(const f32x4*)sp, u1 = *(const f32x4*)(sp + 4);
#pragma unroll
                for (int e = 0; e < 4; ++e) { u[e] = u0[e]; u[4 + e] = u1[e]; } }
#pragma unroll
            for (int tk = 0; tk < 4; ++tk) if (d >= tk && d <= tk + W - 1) {
#pragma unroll
                for (int e = 0; e < 8; ++e) sum[tk][e] += u[e];
                if (d == tk + W - 1) {
#pragma unroll
                    for (int e = 0; e < 8; ++e) uu[tk][e] = u[e]; } } }
        const float inv = 1.f / (float)W;
#pragma unroll
        for (int tk = 0; tk < 4; ++tk)
#pragma unroll
            for (int e = 0; e < 8; ++e) dd[tk][e] = sum[tk][e] * inv - uu[tk][e]; }
}
__device__ __forceinline__ void pool_items(const Args& a, LAS unsigned char* lds) {
    const int tid = threadIdx.x, lane = tid & 63, wave = tid >> 6, fr = lane & 15, fq = lane >> 4, G = gridDim.x;
    const bf16_t* P = (const bf16_t*)(a.ws + WS_PROJ); const bf16_t* WPW = (const bf16_t*)(a.ws + WS_WPW); bf16_t* PM = (bf16_t*)(a.ws + WS_PM);
    const float* spool = a.in[2]; const float* pscale = a.in[18];
    __syncthreads();
    for (int item = G - 1 - (int)blockIdx.x; item < 544; item += G) {
        const int grp = 3 - item / 136, tile = item % 136, R0 = tile * 128;
        { const int oc = tid & 15, t0 = (tid >> 4) * 4, ccol = grp * 128 + oc * 8; float dd[4][8];
          if (grp == 0) pool_d4<2>(P, spool, R0 + t0, ccol, dd); else if (grp == 1) pool_d4<4>(P, spool, R0 + t0, ccol, dd);
          else if (grp == 2) pool_d4<8>(P, spool, R0 + t0, ccol, dd); else pool_d4<16>(P, spool, R0 + t0, ccol, dd);
#pragma unroll
          for (int tk = 0; tk < 4; ++tk) { u32x4 wv; wv.x = cvt_pk_bf16(dd[tk][0], dd[tk][1]); wv.y = cvt_pk_bf16(dd[tk][2], dd[tk][3]); wv.z = cvt_pk_bf16(dd[tk][4], dd[tk][5]); wv.w = cvt_pk_bf16(dd[tk][6], dd[tk][7]);
              *(LAS u32x4*)(lds + (t0 + tk) * LSTR + oc * 16) = wv; } }
        bf16x8 wf[4][8];
#pragma unroll
        for (int ks = 0; ks < 4; ++ks)
#pragma unroll
            for (int nf = 0; nf < 8; ++nf) wf[ks][nf] = *(const bf16x8*)(WPW + ((size_t)(grp * 128 + 16 * nf + fr) * 128 + 32 * ks + 8 * fq));
        __syncthreads();
        f32x4 acc[8];
#pragma unroll
        for (int nf = 0; nf < 8; ++nf) acc[nf] = (f32x4){0.f, 0.f, 0.f, 0.f};
#pragma unroll
        for (int ks = 0; ks < 4; ++ks) { const bf16x8 df = *(const LAS bf16x8*)(lds + (16 * wave + fr) * LSTR + ks * 64 + fq * 16);
#pragma unroll
            for (int nf = 0; nf < 8; ++nf) acc[nf] = MFMA16(wf[ks][nf], df, acc[nf]); }
        { const size_t row = (size_t)(R0 + 16 * wave + fr);
#pragma unroll
          for (int nf = 0; nf < 8; ++nf) { const int dc = grp * 128 + 16 * nf + 4 * fq;
              const f32x4 sc = *(const f32x4*)(pscale + dc); const u32x2 zz = *(const u32x2*)(P + row * NPROJ + C_ZP + dc);
              u32x2 o; o.x = cvt_pk_bf16(acc[nf][0] * sc[0] * bf_lo(zz.x), acc[nf][1] * sc[1] * bf_hi(zz.x)); o.y = cvt_pk_bf16(acc[nf][2] * sc[2] * bf_lo(zz.y), acc[nf][3] * sc[3] * bf_hi(zz.y));
              *(u32x2*)(PM + row * 512 + dc) = o; } }
        __syncthreads();
    }
}

__device__ __forceinline__ void phase6(const Args& a) {
    const int tid = threadIdx.x, lane = tid & 63, wave = tid >> 6, G = gridDim.x;
    const float* ssp = (const float*)(a.ws + WS_SSP); const float* fg = a.in[22]; const bf16_t* xb = (const bf16_t*)(a.ws + WS_YZ);
    f32x4 gv[4];
#pragma unroll
    for (int j = 0; j < 4; ++j) gv[j] = *(const f32x4*)(fg + 4 * lane + 256 * j);
    for (int r0 = (blockIdx.x * 8 + wave) * 4; r0 < TP; r0 += G * 32) {
        float sv[4]; f32x4 v[4][4];
#pragma unroll
        for (int u = 0; u < 4; ++u) { sv[u] = lane < 16 ? ssp[(size_t)(r0 + u) * 16 + lane] : 0.f;
#pragma unroll
            for (int j = 0; j < 4; ++j) { const u32x2 w = *(const u32x2*)(xb + (size_t)(r0 + u) * 1024 + 4 * lane + 256 * j); v[u][j] = (f32x4){bf_lo(w.x), bf_hi(w.x), bf_lo(w.y), bf_hi(w.y)}; } }
#pragma unroll
        for (int u = 0; u < 4; ++u) { const float rstd = rsqrtf(wave_sum(sv[u]) * (1.f / 1024.f) + EPS);
#pragma unroll
            for (int j = 0; j < 4; ++j) *(f32x4*)(a.out + (size_t)(r0 + u) * 1024 + 4 * lane + 256 * j) = v[u][j] * rstd * gv[j]; }
    }
    for (int row = TP + blockIdx.x * 8 + wave; row < MT; row += G * 8) {
        const float sv = lane < 16 ? ssp[(size_t)row * 16 + lane] : 0.f; f32x4 v[4];
#pragma unroll
        for (int j = 0; j < 4; ++j) { const u32x2 w = *(const u32x2*)(xb + (size_t)row * 1024 + 4 * lane + 256 * j); v[j] = (f32x4){bf_lo(w.x), bf_hi(w.x), bf_lo(w.y), bf_hi(w.y)}; }
        const float rstd = rsqrtf(wave_sum(sv) * (1.f / 1024.f) + EPS);
#pragma unroll
        for (int j = 0; j < 4; ++j) *(f32x4*)(a.out + (size_t)row * 1024 + 4 * lane + 256 * j) = v[j] * rstd * gv[j];
    }
}

__global__ void __launch_bounds__(512, 2) fwd_kernel(Args a) {
    extern __shared__ __attribute__((aligned(16))) unsigned char lds_raw[];
    LAS unsigned char* lds = (LAS unsigned char*)lds_raw;
    cg::grid_group grid = cg::this_grid();
    const int lo = a.ph_lo, hi = a.ph_hi, G = gridDim.x, bid = blockIdx.x;
    unsigned char* ws = a.ws;
#define IN(k) (lo <= (k) && (k) < hi)
    if (lo < 0) grid.sync();
    if (threadIdx.x < 2) ((volatile LAS unsigned*)(lds + LDS_BYTES - 64))[threadIdx.x] = 0u;
    __syncthreads();
    const XcdBarrier bar = xcd_barrier_post((unsigned*)ws, (volatile LAS unsigned*)(lds + LDS_BYTES - 64));
#define SEAM(k) do { if (IN(k) && IN((k) + 1)) xcd_barrier(bar); } while (0)
    if (IN(0)) phase0(a, lds);
    SEAM(0);
    if (IN(1)) phase1(a);
    SEAM(1);
    if (IN(2)) {
        pg8::Gemm g{(const bf16_t*)(ws + WS_H), (const bf16_t*)(ws + WS_WIN), MT, NGEMM, 1024}; pg8::StaticOrder S; S.init(MT, NGEMM, G, bid);
        pg8::EpiProj E{(bf16_t*)(ws + WS_PROJ), (float*)(ws + WS_DT), a.in[13]};
        pg8::gemm_phase<pg8::EpiProj, pg8::StaticOrder, true, true>(lds, g, S, E);
    }
    SEAM(2);
    if (IN(3)) {
        conv_prepass(a, lds);
        acs_prepass(a);
        p3_copies(a);
        pool_items(a, lds);
    }
    SEAM(3);
    if (IN(4)) {
        for (int it = bid; it < 256; it += G) { const int pair = (it & 7) * 4 + (it >> 6), hd = (pair & 3) * 8 + ((it >> 3) & 7);
            ssd_prompt_item(a, lds, pair >> 2, hd); }
        ssd_sample_items(a, lds);
    }
    SEAM(4);
    if (IN(5)) {
        { pg8::Gemm g{(const bf16_t*)(ws + WS_PM), (const bf16_t*)(ws + WS_WP), MT, 1024, 512}; pg8::StaticOrder S; S.init(MT, 1024, G, bid);
          pg8::EpiPoolOut E{(const bf16_t*)(ws + WS_PROJ), (bf16_t*)(ws + WS_H)};
          pg8::gemm_phase<pg8::EpiPoolOut, pg8::StaticOrder, true, true>(lds, g, S, E); }
        { pg8::Gemm g{(const bf16_t*)(ws + WS_YZ), (const bf16_t*)(ws + WS_WS), MT, 1024, 2048}; pg8::StaticOrder S; S.init(MT, 1024, G, bid);
          LAS float* lr = (LAS float*)(lds + 132096); pg8::Unit u0, u1; const bool h0 = S.next(0, u0), h1 = S.next(1, u1);
          { const int k = threadIdx.x, which = k >> 8; if (which == 0 ? h0 : h1) { const size_t row = (size_t)(which ? u1.pm : u0.pm) * 256 + (k & 255); const float* sq = (const float*)(ws + WS_SSQ) + row * 32;
                f32x4 s4 = (f32x4){0.f, 0.f, 0.f, 0.f};
#pragma unroll
                for (int q = 0; q < 8; ++q) s4 += *(const f32x4*)(sq + 4 * q);
                lr[k] = rsqrtf(((s4[0] + s4[1]) + (s4[2] + s4[3])) * (1.f / 2048.f) + EPS); } }
          __syncthreads();
          pg8::EpiSsmOut E{(const bf16_t*)(ws + WS_PROJ), (bf16_t*)(ws + WS_H), lr, h0 ? u0.pm : -1};
          pg8::gemm_phase<pg8::EpiSsmOut, pg8::StaticOrder, true, true>(lds, g, S, E); }
    }
    SEAM(5);
    if (IN(6)) {
        pg8::Gemm g{(const bf16_t*)(ws + WS_H), (const bf16_t*)(ws + WS_WO), MT, 1024, 1024}; pg8::StaticOrder S; S.init(MT, 1024, G, bid);
        pg8::EpiOut E{a.in[0], a.in[1], (const float*)(ws + WS_GATE), (bf16_t*)(ws + WS_YZ), (float*)(ws + WS_SSP)};
        pg8::gemm_phase<pg8::EpiOut, pg8::StaticOrder, true, true>(lds, g, S, E);
    }
    SEAM(6);
    if (IN(7)) phase6(a);
#undef IN
#undef SEAM
}

#ifndef N_LAUNCHES
#define N_LAUNCHES 1
#endif
extern "C" void kernel_launch(void* const* d_in, const int* in_sizes, int n_in, void* d_out, int out_size, void* d_ws, size_t ws_size, hipStream_t stream) {
    static int grid = 0;
    if (grid == 0) {
        if (n_in != 23 || ws_size < WS_END) { fprintf(stderr, "kernel_launch: unexpected n_in %d / ws_size %zu\n", n_in, ws_size); grid = -1; return; }
        int dev = 0, cus = 0, per_cu = 0;
        hipGetDevice(&dev); hipDeviceGetAttribute(&cus, hipDeviceAttributeMultiprocessorCount, dev);
        if (hipFuncSetAttribute((const void*)fwd_kernel, hipFuncAttributeMaxDynamicSharedMemorySize, LDS_BYTES) != hipSuccess) { fprintf(stderr, "kernel_launch: hipFuncSetAttribute failed\n"); grid = -1; return; }
        if (hipOccupancyMaxActiveBlocksPerMultiprocessor(&per_cu, (const void*)fwd_kernel, 512, LDS_BYTES) != hipSuccess || per_cu < 1) { fprintf(stderr, "kernel_launch: occupancy query says %d\n", per_cu); per_cu = 1; }
        (void)hipGetLastError();
        grid = cus > 0 ? cus : 256;
    }
    if (grid < 0) return;
    Args a{};
    for (int i = 0; i < 23; ++i) a.in[i] = (const float*)d_in[i];
    a.out = (float*)d_out; a.ws = (unsigned char*)d_ws;
    if (hipMemsetAsync(d_ws, 0, 16384, stream) != hipSuccess) { fprintf(stderr, "kernel_launch: memset of barrier words failed\n"); return; }
    for (int li = 0; li < N_LAUNCHES; ++li) {
        a.ph_lo = (N_LAUNCHES == 1) ? 0 : li; a.ph_hi = (N_LAUNCHES == 1) ? 8 : li + 1;
        void* args[] = {&a};
        hipError_t e = hipLaunchCooperativeKernel((const void*)fwd_kernel, dim3(grid), dim3(512), args, LDS_BYTES, stream);
        if (e != hipSuccess) { fprintf(stderr, "kernel_launch: cooperative launch failed: %s (grid %d)\n", hipGetErrorString(e), grid); break; }
    }
}
```
